# Optimizing an MI355X kernel written in HIP

```python
import jax, jax.numpy as jnp
from jax import lax
import numpy as np

D_MODEL = 2048
BATCH = 2
SEQ = 4096
DEPTH = 1

CHUNK = 64
Q_BLOCK = 128
ROPE_THETA = 500000.0
N_MEM = 256
EPS = 1e-6

MLA_HEADS = 8
MLA_NOPE = 128
MLA_ROPE = 64
MLA_V = 128
MLA_Q_LORA = 512
MLA_KV_LORA = 256
DSA_HEADS = 8
DSA_HEAD_DIM = 128
DSA_ROT = DSA_HEAD_DIM // 4
IDX_HEADS = 16
IDX_DIM = 64
IDX_ROT = IDX_DIM // 4
TOPK_MAX = 256
X_HEADS = 4
X_HEAD_DIM = 128
D_FF = 4 * D_MODEL

MIX_WIDTH = MLA_HEADS * MLA_V + DSA_HEADS * DSA_HEAD_DIM
IN_SPLITS = (
    MLA_Q_LORA,
    MLA_KV_LORA,
    MLA_ROPE,
    DSA_HEADS * DSA_HEAD_DIM,
    DSA_HEADS * DSA_HEAD_DIM,
    DSA_HEADS * DSA_HEAD_DIM,
    IDX_HEADS * IDX_DIM,
    IDX_DIM,
    IDX_HEADS,
)
D_IN = int(sum(IN_SPLITS))

kernel_name = "hymba_mla_dsa_stream_block"


def rmsnorm(x, g):
    xf = x.astype(jnp.float32)
    y = xf * lax.rsqrt(jnp.mean(xf * xf, axis=-1, keepdims=True) + EPS)
    return (y * g.astype(jnp.float32)).astype(x.dtype)


def rope(x, pos, rot_dim):
    half = rot_dim // 2
    inv_freq = ROPE_THETA ** (-jnp.arange(half, dtype=jnp.float32) / half)
    ang = pos.astype(jnp.float32)[..., None] * inv_freq
    ang = ang.reshape(ang.shape[:2] + (1,) * (x.ndim - 3) + (half,))
    cos, sin = jnp.cos(ang), jnp.sin(ang)
    xf = x.astype(jnp.float32)
    x1, x2, rest = xf[..., :half], xf[..., half:rot_dim], xf[..., rot_dim:]
    out = jnp.concatenate([x1 * cos - x2 * sin, x2 * cos + x1 * sin, rest], axis=-1)
    return out.astype(x.dtype)


def to_blocks(a):
    b, s = a.shape[:2]
    a = a.reshape((b, s // Q_BLOCK, Q_BLOCK) + a.shape[2:])
    return jnp.moveaxis(a, 1, 0)


def from_blocks(a):
    a = jnp.moveaxis(a, 0, 1)
    return a.reshape((a.shape[0], a.shape[1] * a.shape[2]) + a.shape[3:])


def query_chunks(i):
    return (i * Q_BLOCK + jnp.arange(Q_BLOCK)) // CHUNK


def mla_mixer(c_q, c_kv, k_rope, pos, g_cq, g_ckv, w_qb, w_kvb):
    b, s, _ = c_q.shape
    q = (rmsnorm(c_q, g_cq) @ w_qb).reshape(b, s, MLA_HEADS, MLA_NOPE + MLA_ROPE)
    q_nope = q[..., :MLA_NOPE]
    q_rope = rope(q[..., MLA_NOPE:], pos, MLA_ROPE)
    kv = (rmsnorm(c_kv, g_ckv) @ w_kvb).reshape(b, s, MLA_HEADS, MLA_NOPE + MLA_V)
    k_nope, v = kv[..., :MLA_NOPE], kv[..., MLA_NOPE:]
    k_rope = rope(k_rope, pos, MLA_ROPE)
    scale = (MLA_NOPE + MLA_ROPE) ** -0.5
    key_chunk = jnp.arange(s) // CHUNK

    def block(args):
        i, qn, qr = args
        sc = (jnp.einsum('bqhd,bkhd->bhqk', qn, k_nope)
              + jnp.einsum('bqhr,bkr->bhqk', qr, k_rope)).astype(jnp.float32) * scale
        allowed = key_chunk[None, :] <= query_chunks(i)[:, None]
        sc = jnp.where(allowed[None, None], sc, -jnp.inf)
        p = jax.nn.softmax(sc, axis=-1).astype(v.dtype)
        return jnp.einsum('bhqk,bkhd->bqhd', p, v)

    o = lax.map(block, (jnp.arange(s // Q_BLOCK), to_blocks(q_nope), to_blocks(q_rope)))
    return from_blocks(o).reshape(b, s, MLA_HEADS * MLA_V)


def dsa_mixer(q, k, v, q_idx, k_idx, w_idx, pos):
    b, s, _ = q.shape
    q = rope(q.reshape(b, s, DSA_HEADS, DSA_HEAD_DIM), pos, DSA_ROT)
    k = rope(k.reshape(b, s, DSA_HEADS, DSA_HEAD_DIM), pos, DSA_ROT)
    v = v.reshape(b, s, DSA_HEADS, DSA_HEAD_DIM)
    q_idx = rope(q_idx.reshape(b, s, IDX_HEADS, IDX_DIM), pos, IDX_ROT)
    k_idx = rope(k_idx, pos, IDX_ROT)
    w_idx = w_idx * (IDX_HEADS ** -0.5)
    n_sel = min(TOPK_MAX, s // 4)
    key_chunk = jnp.arange(s) // CHUNK
    gather = jax.vmap(lambda arr, idx: arr[idx])

    def block(args):
        i, qb, qib, wb = args
        qc = query_chunks(i)
        logits = jax.nn.relu(jnp.einsum('bqhd,bkd->bqhk', qib, k_idx).astype(jnp.float32) * (IDX_DIM ** -0.5))
        score = jnp.einsum('bqhk,bqh->bqk', logits, wb.astype(jnp.float32))
        allowed = key_chunk[None, :] <= qc[:, None]
        score = jnp.where(allowed[None], score, -jnp.inf)
        _, sel = lax.top_k(score, n_sel)
        sel_ok = (sel // CHUNK) <= qc[None, :, None]
        k_sel = gather(k, sel)
        v_sel = gather(v, sel)
        sc = jnp.einsum('bqhd,bqnhd->bhqn', qb, k_sel).astype(jnp.float32) * (DSA_HEAD_DIM ** -0.5)
        sc = jnp.where(sel_ok[:, None], sc, -jnp.inf)
        p = jax.nn.softmax(sc, axis=-1).astype(v.dtype)
        return jnp.einsum('bhqn,bqnhd->bqhd', p, v_sel)

    o = lax.map(block, (jnp.arange(s // Q_BLOCK), to_blocks(q), to_blocks(q_idx), to_blocks(w_idx)))
    return from_blocks(o).reshape(b, s, DSA_HEADS * DSA_HEAD_DIM)


def memory_cross_attention(h, mem_n, wq, wk, wv, wo):
    b, s, _ = h.shape
    m = mem_n.shape[1]
    q = (h @ wq).reshape(b, s, X_HEADS, X_HEAD_DIM)
    k = (mem_n @ wk).reshape(b, m, X_HEADS, X_HEAD_DIM)
    v = (mem_n @ wv).reshape(b, m, X_HEADS, X_HEAD_DIM)
    sc = jnp.einsum('bshd,bmhd->bhsm', q, k).astype(jnp.float32) * (X_HEAD_DIM ** -0.5)
    p = jax.nn.softmax(sc, axis=-1).astype(v.dtype)
    o = jnp.einsum('bhsm,bmhd->bshd', p, v).reshape(b, s, X_HEADS * X_HEAD_DIM)
    return o @ wo


def setup_inputs(seed: int = 0) -> dict:
    key = jax.random.key(seed)
    ks = jax.random.split(key, 24)
    f32 = jnp.float32

    def w(k, shape, fan_in):
        return jax.random.normal(k, (DEPTH,) + shape, f32) * (fan_in ** -0.5)

    def gain(k, n):
        return 1.0 + 0.02 * jax.random.normal(k, (DEPTH, n), f32)

    x = jax.random.normal(ks[0], (BATCH, SEQ, D_MODEL), f32)
    mem = jax.random.normal(ks[1], (BATCH, N_MEM, D_MODEL), f32)
    offset = jax.random.randint(ks[2], (BATCH, 1), 0, 16, dtype=jnp.int32) * CHUNK
    positions = (offset + jnp.arange(SEQ, dtype=jnp.int32)[None, :]).astype(jnp.int32)
    return {
        "x": x,
        "mem": mem,
        "positions": positions,
        "g_mix": gain(ks[3], D_MODEL),
        "w_in": w(ks[4], (D_MODEL, D_IN), D_MODEL),
        "g_cq": gain(ks[5], MLA_Q_LORA),
        "g_ckv": gain(ks[6], MLA_KV_LORA),
        "w_qb": w(ks[7], (MLA_Q_LORA, MLA_HEADS * (MLA_NOPE + MLA_ROPE)), MLA_Q_LORA),
        "w_kvb": w(ks[8], (MLA_KV_LORA, MLA_HEADS * (MLA_NOPE + MLA_V)), MLA_KV_LORA),
        "w_out": w(ks[9], (MIX_WIDTH, D_MODEL), MIX_WIDTH),
        "g_cross": gain(ks[10], D_MODEL),
        "g_mem": gain(ks[11], D_MODEL),
        "w_q_cross": w(ks[12], (D_MODEL, X_HEADS * X_HEAD_DIM), D_MODEL),
        "w_k_cross": w(ks[13], (D_MODEL, X_HEADS * X_HEAD_DIM), D_MODEL),
        "w_v_cross": w(ks[14], (D_MODEL, X_HEADS * X_HEAD_DIM), D_MODEL),
        "w_o_cross": w(ks[15], (X_HEADS * X_HEAD_DIM, D_MODEL), X_HEADS * X_HEAD_DIM),
        "g_mlp": gain(ks[16], D_MODEL),
        "w_up": w(ks[17], (D_MODEL, D_FF), D_MODEL),
        "w_down": w(ks[18], (D_FF, D_MODEL), D_FF),
        "g_final": 1.0 + 0.02 * jax.random.normal(ks[19], (D_MODEL,), f32),
    }


def reference(x, mem, positions, g_mix, w_in, g_cq, g_ckv, w_qb, w_kvb, w_out,
              g_cross, g_mem, w_q_cross, w_k_cross, w_v_cross, w_o_cross,
              g_mlp, w_up, w_down, g_final):
    offsets = np.cumsum(np.array(IN_SPLITS))[:-1].tolist()
    for l in range(DEPTH):
        h = rmsnorm(x, g_mix[l])
        c_q, c_kv, k_rope, q_d, k_d, v_d, q_idx, k_idx, w_idx = jnp.split(h @ w_in[l], offsets, axis=-1)
        a = mla_mixer(c_q, c_kv, k_rope, positions, g_cq[l], g_ckv[l], w_qb[l], w_kvb[l])
        bb = dsa_mixer(q_d, k_d, v_d, q_idx, k_idx, w_idx, positions)
        x = x + jnp.concatenate([a, bb], axis=-1) @ w_out[l]
        hc = rmsnorm(x, g_cross[l])
        mem_n = rmsnorm(mem, g_mem[l])
        x = x + memory_cross_attention(hc, mem_n, w_q_cross[l], w_k_cross[l], w_v_cross[l], w_o_cross[l])
        hm = rmsnorm(x, g_mlp[l])
        x = x + jnp.square(jax.nn.relu(hm @ w_up[l])) @ w_down[l]
    return rmsnorm(x, g_final)
```

```cpp
#include <hip/hip_runtime.h>
#include <cstdio>
#include <cstdint>
namespace slow {
constexpr int Bn = 2, S = 4096, T = Bn * S, DM = 2048, DIN = 5008, NMEM = 256, DFF = 8192;
constexpr float EPS = 1e-6f;
constexpr double R32 = 0.6636012376960885;
constexpr double R16 = 0.44036660267178046;
constexpr double R8  = 0.19392274474868576;

__device__ __forceinline__ void sincos_d(double a, double& s, double& c) {
    const double TWO_OVER_PI = 0.63661977236758134308, PIO2_HI = 1.57079632679489655800e+00, PIO2_LO = 6.12323399573676603587e-17;
    const double n = rint(a * TWO_OVER_PI);
    double r = fma(-n, PIO2_HI, a); r = fma(-n, PIO2_LO, r);
    const double r2 = r * r;
    double sp = -1.0 / 1307674368000.0;
    sp = fma(sp, r2, 1.0 / 6227020800.0); sp = fma(sp, r2, -1.0 / 39916800.0); sp = fma(sp, r2, 1.0 / 362880.0);
    sp = fma(sp, r2, -1.0 / 5040.0); sp = fma(sp, r2, 1.0 / 120.0); sp = fma(sp, r2, -1.0 / 6.0); sp = fma(sp * r2, r, r);
    double cp = 1.0 / 20922789888000.0;
    cp = fma(cp, r2, -1.0 / 87178291200.0); cp = fma(cp, r2, 1.0 / 479001600.0); cp = fma(cp, r2, -1.0 / 3628800.0);
    cp = fma(cp, r2, 1.0 / 40320.0); cp = fma(cp, r2, -1.0 / 720.0); cp = fma(cp, r2, 1.0 / 24.0); cp = fma(cp, r2, -0.5); cp = fma(cp, r2, 1.0);
    const int q = ((int)n) & 3;
    s = (q == 0) ? sp : (q == 1) ? cp : (q == 2) ? -sp : -cp;
    c = (q == 0) ? cp : (q == 1) ? -sp : (q == 2) ? -cp : sp;
}
__device__ __forceinline__ double ipow(double r, int i) { double v = 1.0; for (int k = 0; k < i; ++k) v *= r; return v; }

__global__ __launch_bounds__(256) void k_rmsnorm(const float* in, int ldi, const float* __restrict__ g, float* out, int ldo, int n) {
    __shared__ float red[4];
    const int row = blockIdx.x; const float* x = in + (size_t)row * ldi; float ss = 0.f;
    for (int i = threadIdx.x; i < n; i += 256) { const float v = x[i]; ss += v * v; }
    for (int o = 32; o > 0; o >>= 1) ss += __shfl_xor(ss, o);
    if ((threadIdx.x & 63) == 0) red[threadIdx.x >> 6] = ss;
    __syncthreads();
    const float tot = red[0] + red[1] + red[2] + red[3];
    const float rs = 1.0f / sqrtf(tot / (float)n + EPS);
    for (int i = threadIdx.x; i < n; i += 256) out[(size_t)row * ldo + i] = x[i] * rs * g[i];
}

template <int MODE>
__global__ __launch_bounds__(256) void k_sgemm(const float* __restrict__ A, int lda, const float* __restrict__ Bm, int ldb, float* C, int ldc,
                                               const float* R, int ldr, int M, int N, int K) {
    __shared__ float As[16][68]; __shared__ float Bs[16][68];
    const int tid = threadIdx.x, tx = tid & 15, ty = tid >> 4, m0 = blockIdx.y * 64, n0 = blockIdx.x * 64;
    float acc[4][4];
#pragma unroll
    for (int i = 0; i < 4; ++i)
#pragma unroll
        for (int j = 0; j < 4; ++j) acc[i][j] = 0.f;
    const int ar = tid >> 2, ac = (tid & 3) * 4, br = tid >> 4, bc = (tid & 15) * 4;
    for (int k0 = 0; k0 < K; k0 += 16) {
        const float4 av = *(const float4*)(A + (size_t)(m0 + ar) * lda + k0 + ac);
        float4 bv = make_float4(0.f, 0.f, 0.f, 0.f);
        if (n0 + bc < N) bv = *(const float4*)(Bm + (size_t)(k0 + br) * ldb + n0 + bc);
        __syncthreads();
        As[ac + 0][ar] = av.x; As[ac + 1][ar] = av.y; As[ac + 2][ar] = av.z; As[ac + 3][ar] = av.w;
        *(float4*)&Bs[br][bc] = bv;
        __syncthreads();
#pragma unroll
        for (int k = 0; k < 16; ++k) {
            const float4 a = *(const float4*)&As[k][ty * 4]; const float4 b = *(const float4*)&Bs[k][tx * 4];
            const float aa[4] = {a.x, a.y, a.z, a.w}, bb[4] = {b.x, b.y, b.z, b.w};
#pragma unroll
            for (int i = 0; i < 4; ++i)
#pragma unroll
                for (int j = 0; j < 4; ++j) acc[i][j] = fmaf(aa[i], bb[j], acc[i][j]);
        }
    }
#pragma unroll
    for (int i = 0; i < 4; ++i) {
        const int r = m0 + ty * 4 + i;
#pragma unroll
        for (int j = 0; j < 4; ++j) {
            const int c = n0 + tx * 4 + j;
            if (c < N) {
                float v = acc[i][j];
                if (MODE == 1) v += R[(size_t)r * ldr + c];
                if (MODE == 2) { v = v > 0.f ? v : 0.f; v = v * v; }
                C[(size_t)r * ldc + c] = v;
            }
        }
    }
}

__global__ __launch_bounds__(256) void k_rope(float* buf, int ld, int col0, int nh, int hd, int rot, const int* __restrict__ pos, double rbase) {
    const int half = rot / 2; const long total = (long)T * nh * half; const long idx = (long)blockIdx.x * 256 + threadIdx.x;
    if (idx >= total) return;
    const int i = (int)(idx % half); const int h = (int)((idx / half) % nh); const int t = (int)(idx / ((long)half * nh));
    const double ang = (double)pos[t] * ipow(rbase, i); double s, c; sincos_d(ang, s, c);
    float* p = buf + (size_t)t * ld + col0 + h * hd;
    const float x1 = p[i], x2 = p[i + half];
    p[i] = (float)((double)x1 * c - (double)x2 * s); p[i + half] = (float)((double)x2 * c + (double)x1 * s);
}

__global__ __launch_bounds__(64) void k_mla(const float* __restrict__ q, const float* __restrict__ kv, const float* __restrict__ kr, int ldkr, float* __restrict__ out) {
    __shared__ float sc[4096]; __shared__ float qs[192];
    const int t = blockIdx.x >> 3, h = blockIdx.x & 7, lane = threadIdx.x, b = t / S, tl = t % S, nk = ((tl >> 6) + 1) * 64;
    for (int i = lane; i < 192; i += 64) qs[i] = q[(size_t)t * 1536 + h * 192 + i];
    __syncthreads();
    const float scale = 0.07216878364870322f;
    float mx = -3.0e38f;
    for (int s = lane; s < nk; s += 64) {
        const float* kn = kv + (size_t)(b * S + s) * 2048 + h * 256; const float* krr = kr + (size_t)(b * S + s) * ldkr;
        float d = 0.f;
        for (int i = 0; i < 128; i += 4) { const float4 kk = *(const float4*)(kn + i); d += qs[i] * kk.x + qs[i + 1] * kk.y + qs[i + 2] * kk.z + qs[i + 3] * kk.w; }
        for (int i = 0; i < 64; i += 4) { const float4 kk = *(const float4*)(krr + i); d += qs[128 + i] * kk.x + qs[129 + i] * kk.y + qs[130 + i] * kk.z + qs[131 + i] * kk.w; }
        d *= scale; sc[s] = d; mx = fmaxf(mx, d);
    }
    for (int o = 32; o > 0; o >>= 1) mx = fmaxf(mx, __shfl_xor(mx, o));
    float sum = 0.f;
    for (int s = lane; s < nk; s += 64) { const float p = expf(sc[s] - mx); sc[s] = p; sum += p; }
    for (int o = 32; o > 0; o >>= 1) sum += __shfl_xor(sum, o);
    __syncthreads();
    float o0 = 0.f, o1 = 0.f;
    for (int s = 0; s < nk; ++s) { const float* v = kv + (size_t)(b * S + s) * 2048 + h * 256 + 128; const float p = sc[s]; o0 += p * v[lane]; o1 += p * v[lane + 64]; }
    const float inv = 1.0f / sum;
    out[(size_t)t * 1024 + h * 128 + lane] = o0 * inv; out[(size_t)t * 1024 + h * 128 + lane + 64] = o1 * inv;
}

__device__ __forceinline__ unsigned fkey(float f) { const unsigned u = __float_as_uint(f); return (u & 0x80000000u) ? ~u : (u | 0x80000000u); }

__global__ __launch_bounds__(256) void k_dsa(const float* __restrict__ pB, float* __restrict__ out) {
    constexpr int LD = 4176;
    __shared__ float sc[4096]; __shared__ float qi[1024]; __shared__ float wi[16]; __shared__ int sel[256]; __shared__ int cnt[8]; __shared__ float red[8];
    __shared__ float pr[256]; __shared__ float qd[128]; __shared__ float part[256];
    const int t = blockIdx.x, tid = threadIdx.x, lane = tid & 63, w = tid >> 6, b = t / S, tl = t % S, nk = ((tl >> 6) + 1) * 64;
    const float* row = pB + (size_t)t * LD;
    for (int i = tid; i < 1024; i += 256) qi[i] = row[3072 + i];
    if (tid < 16) wi[tid] = row[4160 + tid] * 0.25f;
    __syncthreads();
    for (int s = tid; s < nk; s += 256) {
        const float* kk = pB + (size_t)(b * S + s) * LD + 4096; float kreg[64];
#pragma unroll
        for (int i = 0; i < 64; ++i) kreg[i] = kk[i];
        float tot = 0.f;
        for (int h = 0; h < 16; ++h) { float d = 0.f;
#pragma unroll
            for (int i = 0; i < 64; ++i) d += qi[h * 64 + i] * kreg[i];
            d *= 0.125f; d = d > 0.f ? d : 0.f; tot += d * wi[h]; }
        sc[s] = tot;
    }
    __syncthreads();
    unsigned thr = 0u; int n_gt = 0;
    if (nk > 256) {
        unsigned prefix = 0u;
        for (int bit = 31; bit >= 0; --bit) {
            const unsigned cand = prefix | (1u << bit); int c = 0;
            for (int s = tid; s < nk; s += 256) c += (fkey(sc[s]) >= cand) ? 1 : 0;
            for (int o = 32; o > 0; o >>= 1) c += __shfl_xor(c, o);
            __syncthreads();
            if (lane == 0) cnt[w] = c;
            __syncthreads();
            const int totc = cnt[0] + cnt[1] + cnt[2] + cnt[3];
            if (totc >= 256) prefix = cand;
        }
        thr = prefix; int c = 0;
        for (int s = tid; s < nk; s += 256) c += (fkey(sc[s]) > thr) ? 1 : 0;
        for (int o = 32; o > 0; o >>= 1) c += __shfl_xor(c, o);
        __syncthreads();
        if (lane == 0) cnt[w] = c;
        __syncthreads();
        n_gt = cnt[0] + cnt[1] + cnt[2] + cnt[3];
    }
    const int per = (nk + 255) / 256;
    int mycount = 0;
    for (int j = 0; j < per; ++j) { const int s = tid * per + j; if (s < nk) { const unsigned k = fkey(sc[s]); bool in = (nk <= 256) || (k > thr);
            if (!in && k == thr) { int rk = 0; for (int s2 = 0; s2 < s; ++s2) rk += (fkey(sc[s2]) == thr) ? 1 : 0; in = rk < 256 - n_gt; }
            mycount += in ? 1 : 0; } }
    int incl = mycount;
    for (int o = 1; o < 64; o <<= 1) { const int v = __shfl_up(incl, o); if (lane >= o) incl += v; }
    __syncthreads();
    if (lane == 63) cnt[4 + w] = incl;
    __syncthreads();
    int base = incl - mycount; for (int i = 0; i < w; ++i) base += cnt[4 + i];
    const int nsel = cnt[4] + cnt[5] + cnt[6] + cnt[7];
    for (int j = 0; j < per; ++j) { const int s = tid * per + j; if (s < nk) { const unsigned k = fkey(sc[s]); bool in = (nk <= 256) || (k > thr);
            if (!in && k == thr) { int rk = 0; for (int s2 = 0; s2 < s; ++s2) rk += (fkey(sc[s2]) == thr) ? 1 : 0; in = rk < 256 - n_gt; }
            if (in) { if (base < 256) sel[base] = s; ++base; } } }
    __syncthreads();
    const int ns = nsel < 256 ? nsel : 256;
    for (int h = 0; h < 8; ++h) {
        if (tid < 128) qd[tid] = row[h * 128 + tid];
        __syncthreads();
        float lg = -3.0e38f;
        if (tid < ns) { const float* kk = pB + (size_t)(b * S + sel[tid]) * LD + 1024 + h * 128; float d = 0.f;
            for (int i = 0; i < 128; i += 4) { const float4 k4 = *(const float4*)(kk + i); d += qd[i] * k4.x + qd[i + 1] * k4.y + qd[i + 2] * k4.z + qd[i + 3] * k4.w; }
            lg = d * 0.08838834764831845f; }
        float mx = lg; for (int o = 32; o > 0; o >>= 1) mx = fmaxf(mx, __shfl_xor(mx, o));
        if (lane == 0) red[w] = mx;
        __syncthreads();
        mx = fmaxf(fmaxf(red[0], red[1]), fmaxf(red[2], red[3]));
        const float p = (tid < ns) ? expf(lg - mx) : 0.f; pr[tid] = p;
        float sm = p; for (int o = 32; o > 0; o >>= 1) sm += __shfl_xor(sm, o);
        if (lane == 0) red[4 + w] = sm;
        __syncthreads();
        const float tot = red[4] + red[5] + red[6] + red[7];
        const int d = tid & 127, hf = tid >> 7; float o = 0.f;
        for (int n = hf; n < ns; n += 2) o += pr[n] * pB[(size_t)(b * S + sel[n]) * LD + 2048 + h * 128 + d];
        part[tid] = o;
        __syncthreads();
        if (tid < 128) out[(size_t)t * 1024 + h * 128 + tid] = (part[tid] + part[tid + 128]) / tot;
        __syncthreads();
    }
}

__global__ __launch_bounds__(64) void k_cross(const float* __restrict__ qc, const float* __restrict__ kc, const float* __restrict__ vc, float* __restrict__ out) {
    __shared__ float qs[128]; __shared__ float pr[256];
    const int t = blockIdx.x >> 2, h = blockIdx.x & 3, lane = threadIdx.x, b = t / S;
    qs[lane] = qc[(size_t)t * 512 + h * 128 + lane]; qs[lane + 64] = qc[(size_t)t * 512 + h * 128 + lane + 64];
    __syncthreads();
    float lg[4]; float mx = -3.0e38f;
#pragma unroll
    for (int j = 0; j < 4; ++j) { const float* kk = kc + (size_t)(b * NMEM + lane + 64 * j) * 512 + h * 128; float d = 0.f;
        for (int i = 0; i < 128; i += 4) { const float4 k4 = *(const float4*)(kk + i); d += qs[i] * k4.x + qs[i + 1] * k4.y + qs[i + 2] * k4.z + qs[i + 3] * k4.w; }
        lg[j] = d * 0.08838834764831845f; mx = fmaxf(mx, lg[j]); }
    for (int o = 32; o > 0; o >>= 1) mx = fmaxf(mx, __shfl_xor(mx, o));
    float sm = 0.f;
#pragma unroll
    for (int j = 0; j < 4; ++j) { const float p = expf(lg[j] - mx); pr[lane + 64 * j] = p; sm += p; }
    for (int o = 32; o > 0; o >>= 1) sm += __shfl_xor(sm, o);
    __syncthreads();
    float o0 = 0.f, o1 = 0.f;
    for (int m = 0; m < NMEM; ++m) { const float* v = vc + (size_t)(b * NMEM + m) * 512 + h * 128; o0 += pr[m] * v[lane]; o1 += pr[m] * v[lane + 64]; }
    out[(size_t)t * 512 + h * 128 + lane] = o0 / sm; out[(size_t)t * 512 + h * 128 + lane + 64] = o1 / sm;
}

template <int MODE> static void gemm(hipStream_t st, const float* A, int lda, const float* B, int ldb, float* C, int ldc, const float* R, int ldr, int M, int N, int K) {
    hipLaunchKernelGGL(k_sgemm<MODE>, dim3((N + 63) / 64, M / 64), dim3(256), 0, st, A, lda, B, ldb, C, ldc, R, ldr, M, N, K);
}
static void rope(hipStream_t st, float* buf, int ld, int col0, int nh, int hd, int rot, const int* pos, double rbase) {
    const long total = (long)T * nh * (rot / 2);
    hipLaunchKernelGGL(k_rope, dim3((unsigned)((total + 255) / 256)), dim3(256), 0, st, buf, ld, col0, nh, hd, rot, pos, rbase);
}

static void forward(void* const* d_in, float* y_out, float* ws, hipStream_t st) {
    const float* x = (const float*)d_in[0]; const float* mem = (const float*)d_in[1]; const int* pos = (const int*)d_in[2];
    const float* g_mix = (const float*)d_in[3]; const float* w_in = (const float*)d_in[4]; const float* g_cq = (const float*)d_in[5]; const float* g_ckv = (const float*)d_in[6];
    const float* w_qb = (const float*)d_in[7]; const float* w_kvb = (const float*)d_in[8]; const float* w_out = (const float*)d_in[9]; const float* g_cross = (const float*)d_in[10];
    const float* g_mem = (const float*)d_in[11]; const float* wq = (const float*)d_in[12]; const float* wk = (const float*)d_in[13]; const float* wv = (const float*)d_in[14];
    const float* wo = (const float*)d_in[15]; const float* g_mlp = (const float*)d_in[16]; const float* w_up = (const float*)d_in[17]; const float* w_down = (const float*)d_in[18];
    const float* g_final = (const float*)d_in[19];
    float* H   = ws;
    float* AB  = H + (size_t)T * 2048;
    float* BIG = AB + (size_t)T * 2048;
    float* pA = BIG;
    float* q = pA + (size_t)T * 832;
    float* kv = q + (size_t)T * 1536;
    hipLaunchKernelGGL(k_rmsnorm, dim3(T), dim3(256), 0, st, x, 2048, g_mix, H, 2048, 2048);
    gemm<0>(st, H, 2048, w_in, DIN, pA, 832, nullptr, 0, T, 832, 2048);
    hipLaunchKernelGGL(k_rmsnorm, dim3(T), dim3(256), 0, st, (const float*)pA, 832, g_cq, pA, 832, 512);
    hipLaunchKernelGGL(k_rmsnorm, dim3(T), dim3(256), 0, st, (const float*)(pA + 512), 832, g_ckv, pA + 512, 832, 256);
    gemm<0>(st, pA, 832, w_qb, 1536, q, 1536, nullptr, 0, T, 1536, 512);
    gemm<0>(st, pA + 512, 832, w_kvb, 2048, kv, 2048, nullptr, 0, T, 2048, 256);
    rope(st, q, 1536, 128, 8, 192, 64, pos, R32);
    rope(st, pA, 832, 768, 1, 64, 64, pos, R32);
    float* MA = AB;
    float* MB = AB + (size_t)T * 1024;
    hipLaunchKernelGGL(k_mla, dim3(T * 8), dim3(64), 0, st, (const float*)q, (const float*)kv, (const float*)(pA + 768), 832, MA);
    float* pB = BIG;
    gemm<0>(st, H, 2048, w_in + 832, DIN, pB, 4176, nullptr, 0, T, 4176, 2048);
    rope(st, pB, 4176, 0, 8, 128, 32, pos, R16);
    rope(st, pB, 4176, 1024, 8, 128, 32, pos, R16);
    rope(st, pB, 4176, 3072, 16, 64, 16, pos, R8);
    rope(st, pB, 4176, 4096, 1, 64, 16, pos, R8);
    hipLaunchKernelGGL(k_dsa, dim3(T), dim3(256), 0, st, (const float*)pB, MB);
    float* X = H;
    gemm<1>(st, MA, 1024, w_out, 2048, X, 2048, x, 2048, T, 2048, 1024);
    gemm<1>(st, MB, 1024, w_out + (size_t)1024 * 2048, 2048, X, 2048, X, 2048, T, 2048, 1024);
    float* hc = BIG;
    float* memn = hc + (size_t)T * 2048;
    float* qc = memn + (size_t)512 * 2048;
    float* kc = qc + (size_t)T * 512;
    float* vc = kc + (size_t)512 * 512;
    float* oc = vc + (size_t)512 * 512;
    hipLaunchKernelGGL(k_rmsnorm, dim3(T), dim3(256), 0, st, (const float*)X, 2048, g_cross, hc, 2048, 2048);
    hipLaunchKernelGGL(k_rmsnorm, dim3(Bn * NMEM), dim3(256), 0, st, mem, 2048, g_mem, memn, 2048, 2048);
    gemm<0>(st, hc, 2048, wq, 512, qc, 512, nullptr, 0, T, 512, 2048);
    gemm<0>(st, memn, 2048, wk, 512, kc, 512, nullptr, 0, Bn * NMEM, 512, 2048);
    gemm<0>(st, memn, 2048, wv, 512, vc, 512, nullptr, 0, Bn * NMEM, 512, 2048);
    hipLaunchKernelGGL(k_cross, dim3(T * 4), dim3(64), 0, st, (const float*)qc, (const float*)kc, (const float*)vc, oc);
    gemm<1>(st, oc, 512, wo, 2048, X, 2048, X, 2048, T, 2048, 512);
    float* hm = BIG;
    float* u = hm + (size_t)T * 2048;
    hipLaunchKernelGGL(k_rmsnorm, dim3(T), dim3(256), 0, st, (const float*)X, 2048, g_mlp, hm, 2048, 2048);
    for (int r0 = 0; r0 < T; r0 += 1024) {
        gemm<2>(st, hm + (size_t)r0 * 2048, 2048, w_up, DFF, u, DFF, nullptr, 0, 1024, DFF, 2048);
        gemm<1>(st, u, DFF, w_down, 2048, X + (size_t)r0 * 2048, 2048, X + (size_t)r0 * 2048, 2048, 1024, 2048, DFF);
    }
    hipLaunchKernelGGL(k_rmsnorm, dim3(T), dim3(256), 0, st, (const float*)X, 2048, g_final, y_out, 2048, 2048);
}
}

extern "C" void kernel_launch(void* const* d_in, const int* in_sizes, int n_in, void* d_out, int out_size, void* d_ws, size_t ws_size, hipStream_t stream) {
    const size_t need = ((size_t)slow::T * 2048 * 2 + (size_t)slow::T * 4416) * 4;
    if (n_in != 20 || out_size != slow::T * 2048 || ws_size < need) { fprintf(stderr, "kernel_launch: bad shapes (n_in %d out %d ws %zu need %zu)\n", n_in, out_size, ws_size, need); return; }
    slow::forward(d_in, (float*)d_out, (float*)d_ws, stream);
}
```

```cpp
#include <hip/hip_runtime.h>
#include <cstdio>
#include <cstdint>
#define GAS __attribute__((address_space(1)))
#define LAS __attribute__((address_space(3)))
namespace pg8 {
#define PG8_LAS __attribute__((address_space(3)))
typedef unsigned short bf16_t;
typedef short bf16x8 __attribute__((ext_vector_type(8)));
typedef float f32x4 __attribute__((ext_vector_type(4)));
typedef unsigned u32x4 __attribute__((ext_vector_type(4)));
constexpr int BM = 256, BK = 64, HALF = 128, HTB = HALF * BK * 2  , STAGE_BYTES = 8 * HTB, NXCD = 8, WGM = 8;

__host__ __device__ __forceinline__ int lds_byte(int r, int c) { const int st = (r >> 4) * 2 + (c >> 5), rr = r & 15, cc = c & 31, ob = rr * 64 + cc * 2; return st * 1024 + (ob ^ (((ob >> 9) & 1) << 5)); }
__host__ __device__ __forceinline__ void stage_rc(int b, int& R, int& C) { const int st = b / 1024, sb = b % 1024, swz = sb ^ (((sb >> 9) & 1) << 5); R = (st >> 1) * 16 + swz / 64; C = (st & 1) * 32 + (swz % 64) / 2; }
__host__ __device__ __forceinline__ int perm32(int rho) { const int n = rho >> 4, i = rho & 15; return 8 * (i >> 2) + 4 * n + (i & 3); }

struct Unit { int pm, pn; };
struct Gemm { const bf16_t* A; const bf16_t* Bt; int M, N, K; };

struct StaticOrder {
    int nM, nN, nwg, G, c;
    __host__ __device__ void init(int M, int N, int G_, int c_) { nM = M / BM; nN = N / BM; nwg = nM * nN; G = G_; c = c_; }
    __host__ __device__ bool next(int i, Unit& u) const {
        const long L = (long)i * G + c; if (L >= nwg) return false;
        int wgid = (int)L; { const int q = nwg / NXCD, r = nwg % NXCD, xcd = wgid % NXCD, off = wgid / NXCD; wgid = (xcd < r ? xcd * (q + 1) : r * (q + 1) + (xcd - r) * q) + off; }
        const int nig = WGM * nN, gid = wgid / nig, fm = gid * WGM, gsz = (nM - fm) < WGM ? (nM - fm) : WGM;
        u.pm = fm + ((wgid % nig) % gsz); u.pn = (wgid % nig) / gsz; return true;
    }
    __device__ __forceinline__ void a_ready(const Unit&) const {}
    __device__ __forceinline__ void done(const Unit&) const {}
};
__device__ __forceinline__ unsigned cvt_pk_bf16(float lo, float hi) { unsigned r; asm volatile("v_cvt_pk_bf16_f32 %0, %1, %2" : "=v"(r) : "v"(lo), "v"(hi)); return r; }
template <class Epi, class Sched, bool ALIGN_EPI = false, bool SP2 = false>
__device__ __forceinline__ void gemm_phase(PG8_LAS unsigned char* lds, const Gemm g, const Sched& S, const Epi& E, int wave_s) {
    int lane; asm volatile("v_mbcnt_lo_u32_b32 %0, -1, 0\n\tv_mbcnt_hi_u32_b32 %0, -1, %0" : "=v"(lane));
    const int wid = wave_s, tid = wid * 64 + lane, wr = wid >> 2, wc = wid & 3, fr = lane & 15, fq = lane >> 4;
    const int K = g.K, nt = K / BK;
    unsigned voffA[2], voffB[2];
#pragma unroll
    for (int i = 0; i < 2; ++i) { int R, C; stage_rc(tid * 16 + i * 8192, R, C); const int Rb = Epi::PERM ? ((R & ~31) + perm32(R & 31)) : R;
        voffA[i] = (unsigned)(R * K + C) * 2u; voffB[i] = (unsigned)(Rb * K + C) * 2u; }
    const size_t kstep = (size_t)(BK * 2);
    const size_t hstep = (size_t)HALF * K * 2;
    const size_t tstep = 2 * hstep;
    const unsigned ldsw = (unsigned)wid * 1024u;
    const int aoff = lds_byte(wr * 64 + fr, fq * 8), boff = lds_byte(wc * 32 + fr, fq * 8);
#define PG8_SA(b, h) (((b) * 2 + (h)) * HTB)
#define PG8_SB(b, h) ((4 + (b) * 2 + (h)) * HTB)
#define PG8_STAGE(bufoff, gbase, voff) do { _Pragma("unroll") for (int _i = 0; _i < 2; ++_i) \
        __builtin_amdgcn_global_load_lds((const unsigned*)((const char*)(gbase) + (voff)[_i]), (PG8_LAS unsigned*)(lds + (bufoff) + ldsw + _i * 8192), 16, 0, 0); } while (0)
#define PG8_LDA(dst, b, h) do { _Pragma("unroll") for (int m = 0; m < 4; ++m) _Pragma("unroll") for (int k = 0; k < 2; ++k) dst[m][k] = *(const PG8_LAS bf16x8*)(lds + PG8_SA(b, h) + aoff + m * 2048 + k * 1024); } while (0)
#define PG8_LDB(dst, b, h) do { _Pragma("unroll") for (int n = 0; n < 2; ++n) _Pragma("unroll") for (int k = 0; k < 2; ++k) dst[n][k] = *(const PG8_LAS bf16x8*)(lds + PG8_SB(b, h) + boff + n * 2048 + k * 1024); } while (0)
#define PG8_MMA(ai, bj, At, Bt) do { __builtin_amdgcn_s_setprio(1); _Pragma("unroll") for (int m = 0; m < 4; ++m) _Pragma("unroll") for (int n = 0; n < 2; ++n) _Pragma("unroll") for (int k = 0; k < 2; ++k) \
        acc[ai][bj][m][n] = __builtin_amdgcn_mfma_f32_16x16x32_bf16(Bt[n][k], At[m][k], acc[ai][bj][m][n], 0, 0, 0); __builtin_amdgcn_s_setprio(0); } while (0)
#define PG8_WAIT_V(n) asm volatile("s_waitcnt vmcnt(" #n ")" ::: "memory")
#define PG8_WAIT_L(n) asm volatile("s_waitcnt lgkmcnt(" #n ")" ::: "memory")
#define PG8_BAR __builtin_amdgcn_s_barrier()
#define PG8_SCHED __builtin_amdgcn_sched_barrier(0)
    Unit cur, nxt; int ui = 0;
    if (!S.next(0, cur)) return;
    f32x4 acc[2][2][4][2];
#pragma unroll
    for (int a = 0; a < 2; ++a)
#pragma unroll
        for (int b = 0; b < 2; ++b)
#pragma unroll
            for (int m = 0; m < 4; ++m)
#pragma unroll
                for (int n = 0; n < 2; ++n) acc[a][b][m][n] = (f32x4){0.f, 0.f, 0.f, 0.f};
    bf16x8 At[4][2], B0[2][2], B1[2][2];
    const char* cA = (const char*)g.A + (size_t)cur.pm * tstep; const char* cB = (const char*)g.Bt + (size_t)cur.pn * tstep;
    S.a_ready(cur);
    if constexpr (SP2) {
        PG8_STAGE(PG8_SB(0, 0), cB, voffB); PG8_STAGE(PG8_SB(0, 1), cB + hstep, voffB); PG8_STAGE(PG8_SA(0, 0), cA, voffA); PG8_STAGE(PG8_SA(0, 1), cA + hstep, voffA);
        if (wr == 1) PG8_BAR;
        PG8_WAIT_V(2); PG8_BAR;
        PG8_STAGE(PG8_SB(1, 0), cB + kstep, voffB); PG8_STAGE(PG8_SA(1, 0), cA + kstep, voffA); PG8_STAGE(PG8_SB(1, 1), cB + hstep + kstep, voffB);
        PG8_WAIT_V(6); PG8_BAR;
    } else {
        PG8_STAGE(PG8_SB(0, 0), cB, voffB); PG8_STAGE(PG8_SA(0, 0), cA, voffA); PG8_STAGE(PG8_SB(0, 1), cB + hstep, voffB); PG8_STAGE(PG8_SA(0, 1), cA + hstep, voffA);
        if (wr == 1) PG8_BAR;
        PG8_WAIT_V(4); PG8_BAR;
        PG8_STAGE(PG8_SB(1, 0), cB + kstep, voffB); PG8_STAGE(PG8_SA(1, 0), cA + kstep, voffA); PG8_STAGE(PG8_SB(1, 1), cB + hstep + kstep, voffB);
        PG8_WAIT_V(6); PG8_BAR;
    }
    for (;;) {
        const bool has_next = S.next(ui + 1, nxt);
        const char* nA = has_next ? (const char*)g.A + (size_t)nxt.pm * tstep : cA; const char* nB = has_next ? (const char*)g.Bt + (size_t)nxt.pn * tstep : cB;
        for (int t = 0; t < nt; t += 2) {
            const bool last = (t == nt - 2);
            const char* a1 = cA + (size_t)(t + 1) * kstep;
            const char* a2 = last ? nA : cA + (size_t)(t + 2) * kstep; const char* b2 = last ? nB : cB + (size_t)(t + 2) * kstep;
            const char* a3 = a2 + kstep; const char* b3 = b2 + kstep;
            if (last && has_next) S.a_ready(nxt);
            if constexpr (SP2) {
            PG8_LDB(B0, 0, 0); PG8_LDB(B1, 0, 1); PG8_SCHED; PG8_LDA(At, 0, 0); PG8_STAGE(PG8_SA(1, 1), a1 + hstep, voffA);
            PG8_WAIT_V(8); PG8_WAIT_L(0); PG8_BAR; PG8_MMA(0, 0, At, B0); PG8_MMA(0, 1, At, B1); PG8_BAR; PG8_SCHED;
            PG8_LDA(At, 0, 1); PG8_STAGE(PG8_SB(0, 0), b2, voffB); PG8_STAGE(PG8_SB(0, 1), b2 + hstep, voffB); PG8_STAGE(PG8_SA(0, 0), a2, voffA);
            PG8_WAIT_V(8); PG8_WAIT_L(0); PG8_BAR; PG8_MMA(1, 0, At, B0); PG8_MMA(1, 1, At, B1); PG8_BAR; PG8_SCHED;
            PG8_LDB(B0, 1, 0); PG8_LDB(B1, 1, 1); PG8_SCHED; PG8_LDA(At, 1, 0); PG8_STAGE(PG8_SA(0, 1), a2 + hstep, voffA);
            PG8_WAIT_V(8); PG8_WAIT_L(0); PG8_BAR; PG8_MMA(0, 0, At, B0); PG8_MMA(0, 1, At, B1); PG8_BAR; PG8_SCHED;
            PG8_LDA(At, 1, 1); PG8_STAGE(PG8_SB(1, 0), b3, voffB); PG8_STAGE(PG8_SB(1, 1), b3 + hstep, voffB); PG8_STAGE(PG8_SA(1, 0), a3, voffA);
            PG8_WAIT_V(8); PG8_WAIT_L(0); PG8_BAR; PG8_MMA(1, 0, At, B0); PG8_MMA(1, 1, At, B1); PG8_BAR; PG8_SCHED;
            } else {
            PG8_LDB(B0, 0, 0); PG8_SCHED; PG8_LDA(At, 0, 0); PG8_STAGE(PG8_SA(1, 1), a1 + hstep, voffA);
            PG8_WAIT_L(8); PG8_BAR; PG8_WAIT_L(0); PG8_MMA(0, 0, At, B0); PG8_BAR; PG8_SCHED;
            PG8_LDB(B1, 0, 1); PG8_STAGE(PG8_SB(0, 0), b2, voffB);
            PG8_BAR; PG8_WAIT_L(0); PG8_MMA(0, 1, At, B1); PG8_BAR;
            PG8_LDA(At, 0, 1); PG8_STAGE(PG8_SA(0, 0), a2, voffA);
            PG8_BAR; PG8_WAIT_L(0); PG8_MMA(1, 0, At, B0); PG8_BAR; PG8_SCHED;
            PG8_STAGE(PG8_SB(0, 1), b2 + hstep, voffB);
            PG8_WAIT_V(6); PG8_BAR; PG8_MMA(1, 1, At, B1); PG8_BAR;
            PG8_LDB(B0, 1, 0); PG8_SCHED; PG8_LDA(At, 1, 0); PG8_STAGE(PG8_SA(0, 1), a2 + hstep, voffA);
            PG8_WAIT_L(8); PG8_BAR; PG8_WAIT_L(0); PG8_MMA(0, 0, At, B0); PG8_BAR; PG8_SCHED;
            PG8_LDB(B1, 1, 1); PG8_STAGE(PG8_SB(1, 0), b3, voffB);
            PG8_BAR; PG8_WAIT_L(0); PG8_MMA(0, 1, At, B1); PG8_BAR;
            PG8_LDA(At, 1, 1); PG8_STAGE(PG8_SA(1, 0), a3, voffA);
            PG8_BAR; PG8_WAIT_L(0); PG8_MMA(1, 0, At, B0); PG8_BAR; PG8_SCHED;
            PG8_STAGE(PG8_SB(1, 1), b3 + hstep, voffB);
            PG8_WAIT_V(6); PG8_BAR; PG8_MMA(1, 1, At, B1); PG8_BAR;
            }
        }
        if constexpr (ALIGN_EPI) { if (wr == 0) PG8_BAR; }
        if constexpr (!Epi::AFTER_DRAIN) { E(acc, cur, wr, wc, fr, fq); S.done(cur); }
        if (!has_next) break;
#pragma unroll
        for (int a = 0; a < 2; ++a)
#pragma unroll
            for (int b = 0; b < 2; ++b)
#pragma unroll
                for (int m = 0; m < 4; ++m)
#pragma unroll
                    for (int n = 0; n < 2; ++n) acc[a][b][m][n] = (f32x4){0.f, 0.f, 0.f, 0.f};
        cur = nxt; cA = nA; cB = nB; ++ui;
        if constexpr (ALIGN_EPI) { if (wr == 1) PG8_BAR; }
    }
    PG8_WAIT_V(0);
    if constexpr (!ALIGN_EPI) { if (wr == 0) PG8_BAR; }
    PG8_BAR;
    if constexpr (Epi::AFTER_DRAIN) { E.fused(acc, cur, wr, wc, fr, fq, lds, wid, lane); S.done(cur); }
#undef PG8_SA
#undef PG8_SB
#undef PG8_STAGE
#undef PG8_LDA
#undef PG8_LDB
#undef PG8_MMA
#undef PG8_WAIT_V
#undef PG8_WAIT_L
#undef PG8_BAR
#undef PG8_SCHED
}
}
#define XB_TMO      128
#define XB_XCNT(j)  (256  + 64 * (j))
#define XB_XSUB(j)  (1280 + 64 * (j))
#define XB_XGEN(j)  (2304 + 64 * (j))
#define XB_TOP      3328
#define XB_TOPGEN   3392
#define XCD_BAR_WORDS 3456
#define XB_SPIN_CAP (1u << 18)

__device__ __forceinline__ unsigned xb_ld(unsigned* p)              { return __hip_atomic_load(p, __ATOMIC_RELAXED, __HIP_MEMORY_SCOPE_AGENT); }
__device__ __forceinline__ unsigned xb_add(unsigned* p, unsigned v) { return __hip_atomic_fetch_add(p, v, __ATOMIC_RELAXED, __HIP_MEMORY_SCOPE_AGENT); }
__device__ __forceinline__ unsigned xb_xcc_id() { return (unsigned)__builtin_amdgcn_s_getreg((3 << 11) | 20) & 0xFu; }
#define XB_SPIN(cond, bar) do { unsigned _sp = 0; while (cond) { __builtin_amdgcn_s_sleep(1); \
    if ((++_sp & 255u) == 0u) { if (xb_ld(&(bar)[XB_TMO])) break; if (_sp > XB_SPIN_CAP) { atomicAdd(&(bar)[XB_TMO], 1u); break; } } } } while (0)

struct XcdBarrier {
    unsigned* bar; unsigned x;
    volatile LAS unsigned* st;
};

__device__ __forceinline__ XcdBarrier xcd_barrier_post(unsigned* bar, volatile LAS unsigned* st) {
    XcdBarrier b; b.bar = bar; b.x = xb_xcc_id(); b.st = st;
    if (threadIdx.x == 0) (void)xb_add(&bar[XB_XCNT(b.x)], 1u);
    return b;
}
__device__ __forceinline__ void xcd_barrier_complete(unsigned* bar, unsigned x, unsigned& nloc, unsigned& nx) {
    const unsigned G = gridDim.x * gridDim.y * gridDim.z;
    unsigned sum, cnt, mine, sp = 0u;
    for (;;) {
        sum = 0u; cnt = 0u; mine = 0u;
#pragma unroll
        for (unsigned j = 0; j < 16; ++j) { const unsigned c = xb_ld(&bar[XB_XCNT(j)]); sum += c; cnt += (c > 0u) ? 1u : 0u; mine = (j == x) ? c : mine; }
        if (sum == G) break;
        __builtin_amdgcn_s_sleep(1);
        if ((++sp & 255u) == 0u) { if (xb_ld(&bar[XB_TMO])) break; if (sp > XB_SPIN_CAP) { atomicAdd(&bar[XB_TMO], 1u); break; } }
    }
    nloc = mine > 0u ? mine : 1u; nx = cnt > 0u ? cnt : 1u;
}

__device__ __forceinline__ void xcd_barrier(const XcdBarrier& b) {
    asm volatile("s_waitcnt vmcnt(0)" ::: "memory");
    __syncthreads();
    if (threadIdx.x == 0) {
        unsigned* bar = b.bar;
        __builtin_amdgcn_s_waitcnt(0);
        unsigned nloc = b.st[0], nx = b.st[1];
        if (nloc == 0u) { xcd_barrier_complete(bar, b.x, nloc, nx); b.st[0] = nloc; b.st[1] = nx; }
        const unsigned old = xb_add(&bar[XB_XSUB(b.x)], 1u);
        const unsigned gen = old / nloc;
        if (old + 1u == (gen + 1u) * nloc) {
            __builtin_amdgcn_fence(__ATOMIC_RELEASE, "agent");
            asm volatile("s_waitcnt vmcnt(0)" ::: "memory");
            const unsigned og = xb_add(&bar[XB_TOP], 1u);
            const unsigned tg = og / nx;
            if (og + 1u == (tg + 1u) * nx) xb_add(&bar[XB_TOPGEN], 1u);
            else XB_SPIN(xb_ld(&bar[XB_TOPGEN]) == tg, bar);
            __builtin_amdgcn_fence(__ATOMIC_ACQUIRE, "agent");
            xb_add(&bar[XB_XGEN(b.x)], 1u);
            asm volatile("s_waitcnt vmcnt(0)" ::: "memory");
        } else {
            XB_SPIN(xb_ld(&bar[XB_XGEN(b.x)]) == gen, bar);
            __builtin_amdgcn_fence(__ATOMIC_ACQUIRE, "agent");
            asm volatile("s_waitcnt vmcnt(0)" ::: "memory");
        }
    }
    __syncthreads();
}
typedef unsigned short bf16;
typedef float f32x4 __attribute__((ext_vector_type(4)));
typedef float f32x16 __attribute__((ext_vector_type(16)));
typedef short bf16x8 __attribute__((ext_vector_type(8)));
typedef short s16x4 __attribute__((ext_vector_type(4)));
typedef unsigned u32x4 __attribute__((ext_vector_type(4)));
typedef unsigned long long u64;

constexpr int NB = 2, SEQ = 4096, T = NB * SEQ, DM = 2048, DFF = 8192, NMEM = 256, NWAVES = 8;
constexpr float EPS = 1e-6f;
constexpr size_t MiB = 1u << 20;
constexpr size_t WS_CTL = 0, CTL_BYTES = 1 * MiB;
constexpr size_t WS_TABM = 1 * MiB, WS_TABD = 3 * MiB, WS_TABI = 4 * MiB;
constexpr size_t WS_WUP = 5 * MiB, WS_WDN = 37 * MiB, WS_X2B = 69 * MiB, WS_U = 101 * MiB;
constexpr size_t WS_WQB = 229 * MiB, WS_WKVB = 231 * MiB, WS_WOUT = 232 * MiB, WS_WQC = 240 * MiB, WS_WKVC = 242 * MiB, WS_WOC = 246 * MiB;
constexpr size_t WS_MASK = 248 * MiB, WS_CQ = 252 * MiB, WS_CKV = 260 * MiB, WS_END = 264 * MiB;
constexpr size_t WS_H = 5 * MiB, WS_WIN = 37 * MiB, WS_SC = 5 * MiB, WS_QI = 70 * MiB, WS_KI = 86 * MiB, WS_WI = 87 * MiB, WS_KR = 88 * MiB, WS_MEMN = 89 * MiB, WS_KVC = 91 * MiB;
constexpr size_t WS_QD = 101 * MiB, WS_KD = 117 * MiB, WS_VD = 133 * MiB, WS_QN = 149 * MiB, WS_QR = 165 * MiB, WS_KN = 173 * MiB, WS_V = 189 * MiB;
constexpr size_t WS_MIX = 5 * MiB, WS_X1B = 101 * MiB, WS_QC = 133 * MiB, WS_OC = 141 * MiB;
constexpr int CW_BAR = 4096;
constexpr size_t CTL_SSCQ = 64 * 1024, CTL_SSCKV = 96 * 1024, CTL_SS1 = 128 * 1024, CTL_SS2 = 160 * 1024, CTL_SS3 = 192 * 1024;
constexpr long SC_BATCH = 4096L * 2080L;
constexpr int RING_BYTES = 131072, MISC_OFF = RING_BYTES, LDS_BYTES = 147456;

constexpr double R32 = 0.6636012376960885, R16 = 0.44036660267178046, R8 = 0.19392274474868576;

__device__ __forceinline__ int lane_id() { int l; asm volatile("v_mbcnt_lo_u32_b32 %0, -1, 0\n\tv_mbcnt_hi_u32_b32 %0, -1, %0" : "=v"(l)); return l; }
#define LDS_WAIT() asm volatile("s_waitcnt lgkmcnt(0)" ::: "memory")
#define VM_WAIT() asm volatile("s_waitcnt vmcnt(0)" ::: "memory")
__device__ __forceinline__ unsigned cvtpk(float lo, float hi) { unsigned r; asm volatile("v_cvt_pk_bf16_f32 %0, %1, %2" : "=v"(r) : "v"(lo), "v"(hi)); return r; }
__device__ __forceinline__ void st8(bf16* p, f32x4 a, f32x4 b) { u32x4 w; w.x = cvtpk(a[0], a[1]); w.y = cvtpk(a[2], a[3]); w.z = cvtpk(b[0], b[1]); w.w = cvtpk(b[2], b[3]); *(u32x4*)p = w; }
__device__ __forceinline__ float dot4(f32x4 a) { return (a[0] * a[0] + a[1] * a[1]) + (a[2] * a[2] + a[3] * a[3]); }
__device__ __forceinline__ void fadd_agent(float* p, float v) { (void)__hip_atomic_fetch_add(p, v, __ATOMIC_RELAXED, __HIP_MEMORY_SCOPE_AGENT); }
__device__ __forceinline__ void rope8(f32x4& a, f32x4& b, const float* tb) {
    const f32x4 t0 = *(const f32x4*)tb, t1 = *(const f32x4*)(tb + 4);
    float x1 = a[0], x2 = a[1]; a[0] = x1 * t0[0] - x2 * t0[1]; a[1] = x2 * t0[0] + x1 * t0[1];
    x1 = a[2]; x2 = a[3];       a[2] = x1 * t0[2] - x2 * t0[3]; a[3] = x2 * t0[2] + x1 * t0[3];
    x1 = b[0]; x2 = b[1];       b[0] = x1 * t1[0] - x2 * t1[1]; b[1] = x2 * t1[0] + x1 * t1[1];
    x1 = b[2]; x2 = b[3];       b[2] = x1 * t1[2] - x2 * t1[3]; b[3] = x2 * t1[2] + x1 * t1[3];
}

#define EPI_ROWS_BEGIN \
    const int colt0 = wc * 32 + 8 * fq; \
    _Pragma("unroll") for (int ai = 0; ai < 2; ++ai) _Pragma("unroll") for (int m = 0; m < 4; ++m) { \
        const int row = u.pm * 256 + ai * 128 + wr * 64 + m * 16 + fr; \
        f32x4 a0 = acc[ai][0][m][0], a1 = acc[ai][0][m][1], b0 = acc[ai][1][m][0], b1 = acc[ai][1][m][1];
#define EPI_ROWS_END }

struct EpiIn {
    static constexpr bool PERM = true, AFTER_DRAIN = false;
    bf16 *CQ, *CKV, *QD, *KD, *VD, *QI, *KI, *KR; float* WI; float *sscq, *ssckv; const float *tabM, *tabD, *tabI;
    __device__ __forceinline__ void operator()(const f32x4 (&acc)[2][2][4][2], const pg8::Unit& u, int wr, int wc, int fr, int fq) const {
        const int pn = u.pn;
        EPI_ROWS_BEGIN
            if (pn < 3) {
                float s = (dot4(a0) + dot4(a1)) + (dot4(b0) + dot4(b1));
                s += __shfl_xor(s, 16); s += __shfl_xor(s, 32);
                if (pn < 2) { bf16* d = CQ + (size_t)row * 512 + pn * 256 + colt0; st8(d, a0, a1); st8(d + 128, b0, b1); if (fq == 0) fadd_agent(sscq + row, s); }
                else { bf16* d = CKV + (size_t)row * 256 + colt0; st8(d, a0, a1); st8(d + 128, b0, b1); if (fq == 0) fadd_agent(ssckv + row, s); }
            } else if (pn < 11) {
                bf16* d = (pn < 7 ? QD : KD) + (size_t)row * 1024 + ((pn - 3) & 3) * 256 + colt0;
                if (wc == 0) { const float* tb = tabD + ((size_t)row * 16 + 4 * fq) * 2; rope8(a0, a1, tb); rope8(b0, b1, tb); }
                st8(d, a0, a1); st8(d + 128, b0, b1);
            } else if (pn < 15) {
                bf16* d = VD + (size_t)row * 1024 + (pn - 11) * 256 + colt0; st8(d, a0, a1); st8(d + 128, b0, b1);
            } else if (pn < 19) {
                bf16* d = QI + (size_t)row * 1024 + (pn - 15) * 256 + colt0;
                if ((wc & 1) == 0 && fq < 2) { const float* tb = tabI + ((size_t)row * 8 + 4 * fq) * 2; rope8(a0, a1, tb); rope8(b0, b1, tb); }
                st8(d, a0, a1); st8(d + 128, b0, b1);
            } else {
                if (wc < 2) { const float* tb = tabM + ((size_t)row * 32 + 16 * wc + 4 * fq) * 2; rope8(a0, a1, tb); st8(KR + (size_t)row * 64 + 32 * wc + 8 * fq, a0, a1); }
                else { if (wc == 2 && fq < 2) { const float* tb = tabI + ((size_t)row * 8 + 4 * fq) * 2; rope8(a0, a1, tb); } st8(KI + (size_t)row * 64 + 32 * (wc - 2) + 8 * fq, a0, a1); }
                if (wc == 0 && fq < 2) { float* d = WI + (size_t)row * 16 + 8 * fq; *(f32x4*)d = b0 * 0.03125f; *(f32x4*)(d + 4) = b1 * 0.03125f; }
            }
        EPI_ROWS_END
    }
};
struct EpiPlain {
    static constexpr bool PERM = true, AFTER_DRAIN = false;
    bf16* O; int ldc;
    __device__ __forceinline__ void operator()(const f32x4 (&acc)[2][2][4][2], const pg8::Unit& u, int wr, int wc, int fr, int fq) const {
        EPI_ROWS_BEGIN
            bf16* d = O + (size_t)row * ldc + u.pn * 256 + colt0; st8(d, a0, a1); st8(d + 128, b0, b1);
        EPI_ROWS_END
    }
};
struct EpiQ {
    static constexpr bool PERM = true, AFTER_DRAIN = false;
    bf16 *QN, *QR; const float* ss; const float* tabM;
    __device__ __forceinline__ void operator()(const f32x4 (&acc)[2][2][4][2], const pg8::Unit& u, int wr, int wc, int fr, int fq) const {
        const int pn = u.pn;
        EPI_ROWS_BEGIN
            const float rs = 1.0f / sqrtf(ss[row] * (1.0f / 512.0f) + EPS);
            a0 = a0 * rs; a1 = a1 * rs; b0 = b0 * rs; b1 = b1 * rs;
            if (pn < 4) { bf16* d = QN + (size_t)row * 1024 + pn * 256 + colt0; st8(d, a0, a1); st8(d + 128, b0, b1); }
            else { const float* tb = tabM + ((size_t)row * 32 + 16 * (wc & 1) + 4 * fq) * 2; rope8(a0, a1, tb); rope8(b0, b1, tb);
                   bf16* d = QR + (size_t)row * 512 + (pn - 4) * 256 + colt0; st8(d, a0, a1); st8(d + 128, b0, b1); }
        EPI_ROWS_END
    }
};
struct EpiKV {
    static constexpr bool PERM = true, AFTER_DRAIN = false;
    bf16 *KN, *V; const float* ss;
    __device__ __forceinline__ void operator()(const f32x4 (&acc)[2][2][4][2], const pg8::Unit& u, int wr, int wc, int fr, int fq) const {
        const int pn = u.pn;
        EPI_ROWS_BEGIN
            const float rs = 1.0f / sqrtf(ss[row] * (1.0f / 256.0f) + EPS);
            bf16* d = (pn < 4 ? KN : V) + (size_t)row * 1024 + (pn & 3) * 256 + colt0; st8(d, a0 * rs, a1 * rs); st8(d + 128, b0 * rs, b1 * rs);
        EPI_ROWS_END
    }
};
template <bool WITH_BF16> struct EpiRes {
    static constexpr bool PERM = true, AFTER_DRAIN = false;
    const float* R; float* X; bf16* Xb; float* ss;
    __device__ __forceinline__ void operator()(const f32x4 (&acc)[2][2][4][2], const pg8::Unit& u, int wr, int wc, int fr, int fq) const {
        EPI_ROWS_BEGIN
            const size_t off = (size_t)row * 2048 + u.pn * 256 + colt0;
            a0 += *(const f32x4*)(R + off); a1 += *(const f32x4*)(R + off + 4); b0 += *(const f32x4*)(R + off + 128); b1 += *(const f32x4*)(R + off + 132);
            *(f32x4*)(X + off) = a0; *(f32x4*)(X + off + 4) = a1; *(f32x4*)(X + off + 128) = b0; *(f32x4*)(X + off + 132) = b1;
            if (WITH_BF16) { st8(Xb + off, a0, a1); st8(Xb + off + 128, b0, b1); }
            float s = (dot4(a0) + dot4(a1)) + (dot4(b0) + dot4(b1));
            s += __shfl_xor(s, 16); s += __shfl_xor(s, 32);
            if (fq == 0) fadd_agent(ss + row, s);
        EPI_ROWS_END
    }
};
template <int ACT> struct EpiScale {
    static constexpr bool PERM = true, AFTER_DRAIN = false;
    bf16* O; int ldc; const float* ss;
    __device__ __forceinline__ void operator()(const f32x4 (&acc)[2][2][4][2], const pg8::Unit& u, int wr, int wc, int fr, int fq) const {
        EPI_ROWS_BEGIN
            const float rs = 1.0f / sqrtf(ss[row] * (1.0f / 2048.0f) + EPS);
            a0 = a0 * rs; a1 = a1 * rs; b0 = b0 * rs; b1 = b1 * rs;
            if (ACT == 1) {
#pragma unroll
                for (int i = 0; i < 4; ++i) { float v;
                    v = fmaxf(a0[i], 0.f); a0[i] = v * v; v = fmaxf(a1[i], 0.f); a1[i] = v * v; v = fmaxf(b0[i], 0.f); b0[i] = v * v; v = fmaxf(b1[i], 0.f); b1[i] = v * v; }
            }
            bf16* d = O + (size_t)row * ldc + u.pn * 256 + colt0; st8(d, a0, a1); st8(d + 128, b0, b1);
        EPI_ROWS_END
    }
};

struct Frame {
    LAS unsigned char* lds; int tid, lane, wave, vcu, G;
    unsigned char* ws; const void* const* in; float* out;
};
__device__ __forceinline__ float wave_sum(float v) {
#pragma unroll
    for (int o = 1; o < 64; o <<= 1) v += __shfl_xor(v, o);
    return v;
}

__device__ __forceinline__ int ilv(int d, int half) { return (d & 1) ? half + (d >> 1) : (d >> 1); }
__device__ __forceinline__ int srcmap(int id, int n) {
    if (id == 1) {
        if (n < 768) return n;
        if (n < 1792) { const int j = n - 768, h = j >> 7, d = j & 127; return 832 + h * 128 + (d < 32 ? ilv(d, 16) : d); }
        if (n < 2816) { const int j = n - 1792, h = j >> 7, d = j & 127; return 1856 + h * 128 + (d < 32 ? ilv(d, 16) : d); }
        if (n < 3840) return 2880 + (n - 2816);
        if (n < 4864) { const int j = n - 3840, h = j >> 6, d = j & 63; return 3904 + h * 64 + (d < 16 ? ilv(d, 8) : d); }
        const int j = n - 4864;
        if (j < 64) return 768 + ilv(j, 32);
        if (j < 128) { const int d = j - 64; return 4928 + (d < 16 ? ilv(d, 8) : d); }
        if (j < 144) return 4992 + (j - 128);
        return -1;
    }
    if (id == 2) {
        if (n < 1024) { const int h = n >> 7, d = n & 127; return h * 192 + d; }
        const int j = n - 1024, h = j >> 6, d = j & 63; return h * 192 + 128 + ilv(d, 32);
    }
    if (id == 3) {
        if (n < 1024) { const int h = n >> 7, d = n & 127; return h * 256 + d; }
        const int j = n - 1024, h = j >> 7, d = j & 127; return h * 256 + 128 + d;
    }
    return n;
}
__device__ __forceinline__ void transpose_item(const float* W, int K, int Nsrc, bf16* WT, int Ndst, int row_off, int mapid, const float* gain, LAS float* scr, int item, int lane) {
    const int nblk = Ndst / 32, kb = item / nblk, nb = item % nblk, k0 = 64 * kb, n0 = 32 * nb;
    const int nsrc = srcmap(mapid, n0 + (lane & 31));
#pragma unroll 8
    for (int i = 0; i < 32; ++i) { const int kk = 2 * i + (lane >> 5); float v = 0.f;
        if (nsrc >= 0) v = W[(size_t)(k0 + kk) * Nsrc + nsrc];
        if (gain) v *= gain[k0 + kk];
        scr[kk * 33 + (lane & 31)] = v; }
    LDS_WAIT(); asm volatile("" ::: "memory");
    const int c = lane & 7;
#pragma unroll
    for (int j = 0; j < 4; ++j) { const int n = (lane >> 3) + 8 * j; const LAS float* s = scr + (8 * c) * 33 + n;
        u32x4 o; o.x = cvtpk(s[0 * 33], s[1 * 33]); o.y = cvtpk(s[2 * 33], s[3 * 33]); o.z = cvtpk(s[4 * 33], s[5 * 33]); o.w = cvtpk(s[6 * 33], s[7 * 33]);
        *(u32x4*)(WT + (size_t)(row_off + n0 + n) * K + k0 + 8 * c) = o; }
    LDS_WAIT(); asm volatile("" ::: "memory");
}

__device__ __forceinline__ void rms_row_to_bf16(const float* xrow, const float* g, bf16* orow, int lane) {
    const f32x4* xr = (const f32x4*)xrow + lane; const f32x4* gr = (const f32x4*)g + lane;
    f32x4 v[8]; float s = 0.f;
#pragma unroll
    for (int j = 0; j < 8; ++j) { v[j] = xr[64 * j]; s += dot4(v[j]); }
    const float rs = 1.0f / sqrtf(wave_sum(s) * (1.0f / 2048.0f) + EPS);
    unsigned long long* o8 = (unsigned long long*)orow + lane;
#pragma unroll
    for (int j = 0; j < 8; ++j) { const f32x4 gg = gr[64 * j]; const f32x4 y = v[j] * rs * gg;
        o8[64 * j] = (unsigned long long)cvtpk(y[0], y[1]) | ((unsigned long long)cvtpk(y[2], y[3]) << 32); }
}

__device__ __forceinline__ void sincos_d(double a, double& s, double& c) {
    const double TWO_OVER_PI = 0.63661977236758134308, PIO2_HI = 1.57079632679489655800e+00, PIO2_LO = 6.12323399573676603587e-17;
    const double n = rint(a * TWO_OVER_PI);
    double r = fma(-n, PIO2_HI, a); r = fma(-n, PIO2_LO, r);
    const double r2 = r * r;
    double sp = -1.0 / 1307674368000.0;
    sp = fma(sp, r2, 1.0 / 6227020800.0); sp = fma(sp, r2, -1.0 / 39916800.0); sp = fma(sp, r2, 1.0 / 362880.0);
    sp = fma(sp, r2, -1.0 / 5040.0); sp = fma(sp, r2, 1.0 / 120.0); sp = fma(sp, r2, -1.0 / 6.0); sp = fma(sp * r2, r, r);
    double cp = 1.0 / 20922789888000.0;
    cp = fma(cp, r2, -1.0 / 87178291200.0); cp = fma(cp, r2, 1.0 / 479001600.0); cp = fma(cp, r2, -1.0 / 3628800.0);
    cp = fma(cp, r2, 1.0 / 40320.0); cp = fma(cp, r2, -1.0 / 720.0); cp = fma(cp, r2, 1.0 / 24.0); cp = fma(cp, r2, -0.5); cp = fma(cp, r2, 1.0);
    const int q = ((int)n) & 3;
    s = (q == 0) ? sp : (q == 1) ? cp : (q == 2) ? -sp : -cp;
    c = (q == 0) ? cp : (q == 1) ? -sp : (q == 2) ? -cp : sp;
}

namespace att {
constexpr int SHM_V = 16384, SHM_K = 16384, SHM_KR = 9216, QR_WAVE = 4608;
constexpr int OFF_V = 0, OFF_K = 32768, OFF_KR = 65536, OFF_QR = 83968, OFF_WS = 120832;
#define KSWZ(row, colB) ((row) * 256 + ((colB) ^ (((row) & 7) << 4)))
#define SBAR() __builtin_amdgcn_sched_barrier(0)
__device__ __forceinline__ int crow(int r, int hi) { return (r & 3) + 8 * (r >> 2) + 4 * hi; }
__device__ __forceinline__ float mbit(float p, unsigned w, int pos) { return __uint_as_float(__float_as_uint(p) & (unsigned)(((int)(w << (31 - pos))) >> 31)); }

template <int MODE> __device__ __forceinline__ void partialSM(f32x16& p0, f32x16& p1, float& m_reg, float& mn, float& alpha, unsigned wl) {
    constexpr float SCALE = MODE == 0 ? 0.07216878364870322f : 0.08838834764831845f, C = SCALE * 1.4426950408889634f, THRR = 8.f / SCALE;
    float pmax = p0[0];
#pragma unroll
    for (int r = 1; r < 16; ++r) pmax = fmaxf(pmax, p0[r]);
#pragma unroll
    for (int r = 0; r < 16; ++r) pmax = fmaxf(pmax, p1[r]);
    { auto rr = __builtin_amdgcn_permlane32_swap(__float_as_uint(pmax), __float_as_uint(pmax), false, false);
      pmax = fmaxf(__uint_as_float(rr[0]), __uint_as_float(rr[1])); }
    if (__builtin_expect(__all(pmax - m_reg <= THRR), 1)) { mn = m_reg; alpha = 1.f; }
    else { mn = fmaxf(m_reg, pmax); alpha = __builtin_amdgcn_exp2f((m_reg - mn) * C); m_reg = mn; }
    const float mnC = -mn * C;
#pragma unroll
    for (int r = 0; r < 16; ++r) p0[r] = fmaf(p0[r], C, mnC);
#pragma unroll
    for (int r = 0; r < 16; ++r) p1[r] = fmaf(p1[r], C, mnC);
#pragma unroll
    for (int r = 0; r < 16; ++r) p0[r] = __builtin_amdgcn_exp2f(p0[r]);
    if (MODE == 1) {
#pragma unroll
        for (int r = 0; r < 16; ++r) p0[r] = mbit(p0[r], wl, 8 * (r >> 2) + (r & 3));
    }
}
template <int MODE> __device__ __forceinline__ void finishSM(f32x16& p0, f32x16& p1, float alpha, float& l_reg, bf16x8& pa0, bf16x8& pa1, bf16x8& pa2, bf16x8& pa3, unsigned wh) {
#pragma unroll
    for (int r = 0; r < 16; ++r) p1[r] = __builtin_amdgcn_exp2f(p1[r]);
    if (MODE == 1) {
#pragma unroll
        for (int r = 0; r < 16; ++r) p1[r] = mbit(p1[r], wh, 8 * (r >> 2) + (r & 3));
    }
    float ps = 0;
#pragma unroll
    for (int r = 0; r < 16; ++r) ps += p0[r];
#pragma unroll
    for (int r = 0; r < 16; ++r) ps += p1[r];
    { auto rr = __builtin_amdgcn_permlane32_swap(__float_as_uint(ps), __float_as_uint(ps), false, false);
      ps = __uint_as_float(rr[0]) + __uint_as_float(rr[1]); }
    l_reg = l_reg * alpha + ps;
#define PK4(P, BASE, OUT) do { unsigned a0 = cvtpk(P[BASE + 0], P[BASE + 1]), a1 = cvtpk(P[BASE + 2], P[BASE + 3]);   \
    unsigned b0 = cvtpk(P[BASE + 4], P[BASE + 5]), b1 = cvtpk(P[BASE + 6], P[BASE + 7]);                              \
    auto r0 = __builtin_amdgcn_permlane32_swap(a0, b0, false, false); auto r1 = __builtin_amdgcn_permlane32_swap(a1, b1, false, false); \
    u32x4 w = {r0[0], r1[0], r0[1], r1[1]}; OUT = *reinterpret_cast<bf16x8*>(&w); } while (0)
    PK4(p0, 0, pa0); PK4(p0, 8, pa1); PK4(p1, 0, pa2); PK4(p1, 8, pa3);
#undef PK4
}
template <int MODE> __device__ __forceinline__ void qkt(f32x16& p0, f32x16& p1, const char* Ks, const char* KRs, const char* QRs, const bf16x8* qr, int r32, int hi) {
    p0 = f32x16{}; p1 = f32x16{};
#pragma unroll
    for (int d0 = 0; d0 < 8; ++d0) { const int cb = (d0 * 16 + hi * 8) * 2;
        const bf16x8 b0 = *reinterpret_cast<const bf16x8*>(Ks + KSWZ(r32, cb));
        const bf16x8 b1 = *reinterpret_cast<const bf16x8*>(Ks + KSWZ(32 + r32, cb));
        p0 = __builtin_amdgcn_mfma_f32_32x32x16_bf16(b0, qr[d0], p0, 0, 0, 0);
        p1 = __builtin_amdgcn_mfma_f32_32x32x16_bf16(b1, qr[d0], p1, 0, 0, 0); }
    if (MODE == 0) {
#pragma unroll
        for (int d0 = 0; d0 < 4; ++d0) { const int cb = d0 * 32 + hi * 16;
            const bf16x8 b0 = *reinterpret_cast<const bf16x8*>(KRs + r32 * 144 + cb);
            const bf16x8 b1 = *reinterpret_cast<const bf16x8*>(KRs + (32 + r32) * 144 + cb);
            const bf16x8 qf = *reinterpret_cast<const bf16x8*>(QRs + r32 * 144 + cb);
            p0 = __builtin_amdgcn_mfma_f32_32x32x16_bf16(b0, qf, p0, 0, 0, 0);
            p1 = __builtin_amdgcn_mfma_f32_32x32x16_bf16(b1, qf, p1, 0, 0, 0); }
    }
}
__device__ __forceinline__ int v_st(int k, int c) { const int kk = (k & ~0xC) | ((k & 4) << 1) | ((k & 8) >> 1); return ((kk >> 3) * 4 + (c >> 5)) * 512 + ((kk & 7) * 32 + (c & 31)) * 2; }
__device__ __forceinline__ int v_rd_base(int lane) { return ((lane & 3) << 3) | (((lane >> 2) & 3) << 6) | (((lane >> 4) & 1) << 5) | (((lane >> 5) & 1) << 8); }
constexpr int v_rd_off(int d0, int ks, int half) { return d0 * 512 + ks * 4096 + half * 2048; }
template <int OFF> __device__ __forceinline__ s16x4 tr_read(int vb) {
    s16x4 r; asm volatile("ds_read_b64_tr_b16 %0, %1 offset:%2" : "=&v"(r) : "v"(vb), "i"(OFF) : "memory"); return r;
}
template <int D0> __device__ __forceinline__ void pv_one(f32x16& od, int vb, bf16x8 pa0, bf16x8 pa1, bf16x8 pa2, bf16x8 pa3) {
    const s16x4 l0 = tr_read<v_rd_off(D0, 0, 0)>(vb), h0 = tr_read<v_rd_off(D0, 0, 1)>(vb), l1 = tr_read<v_rd_off(D0, 1, 0)>(vb), h1 = tr_read<v_rd_off(D0, 1, 1)>(vb);
    const s16x4 l2 = tr_read<v_rd_off(D0, 2, 0)>(vb), h2 = tr_read<v_rd_off(D0, 2, 1)>(vb), l3 = tr_read<v_rd_off(D0, 3, 0)>(vb), h3 = tr_read<v_rd_off(D0, 3, 1)>(vb);
    asm volatile("s_waitcnt lgkmcnt(0)" ::: "memory"); SBAR();
#define PK(L, H) (bf16x8){L[0], L[1], L[2], L[3], H[0], H[1], H[2], H[3]}
    od = __builtin_amdgcn_mfma_f32_32x32x16_bf16(pa0, PK(l0, h0), od, 0, 0, 0);
    od = __builtin_amdgcn_mfma_f32_32x32x16_bf16(pa1, PK(l1, h1), od, 0, 0, 0);
    od = __builtin_amdgcn_mfma_f32_32x32x16_bf16(pa2, PK(l2, h2), od, 0, 0, 0);
    od = __builtin_amdgcn_mfma_f32_32x32x16_bf16(pa3, PK(l3, h3), od, 0, 0, 0);
#undef PK
}
__device__ __forceinline__ void pv_d0(f32x16* o, int vb, bf16x8 pa0, bf16x8 pa1, bf16x8 pa2, bf16x8 pa3) {
    pv_one<0>(o[0], vb, pa0, pa1, pa2, pa3); pv_one<1>(o[1], vb, pa0, pa1, pa2, pa3); pv_one<2>(o[2], vb, pa0, pa1, pa2, pa3); pv_one<3>(o[3], vb, pa0, pa1, pa2, pa3);
}

template <int MODE>
__device__ __forceinline__ void attn_unit(const bf16* __restrict__ Qb, int ldq, const bf16* __restrict__ Qrb, int ldqr, const bf16* __restrict__ Kh, const bf16* __restrict__ Krh,
                                          const bf16* __restrict__ Vh, int ldk, bf16* __restrict__ Ob, int ldo, const u64* __restrict__ Mb, int NT, int wnt, char* lds, int wave_s) {
    const int lane = lane_id(), wid = wave_s, tid = wid * 64 + lane, r32 = lane & 31, hi = lane >> 5;
    char* V_lds = lds + OFF_V; char* K_lds = lds + OFF_K; char* KR_lds = lds + OFF_KR; char* QR_lds = lds + OFF_QR + wid * QR_WAVE;
    float* ws = (float*)(lds + OFF_WS) + wid * 64; float* li_l = ws; float* al_l = ws + 32;
    float m_reg = -1e30f, l_reg = 0; f32x16 o[4] = {}; bf16x8 qr[8];
    __syncthreads();
    const bf16* Qw = Qb + (long)(wid * 32 + r32) * ldq + hi * 8;
#pragma unroll
    for (int d0 = 0; d0 < 8; ++d0) qr[d0] = *reinterpret_cast<const bf16x8*>(Qw + d0 * 16);
    if (MODE == 0) {
#pragma unroll
        for (int i = 0; i < 4; ++i) { const int id = lane + 64 * i, row = id >> 3, ch = id & 7;
            *reinterpret_cast<bf16x8*>(QR_lds + row * 144 + ch * 16) = *reinterpret_cast<const bf16x8*>(Qrb + (long)(wid * 32 + row) * ldqr + ch * 8); }
    }
    const u64* Mrow = Mb + (long)(wid * 32 + r32) * 64;
    const int sr = tid >> 4, sc = (tid & 15) * 8, vst0 = v_st(sr, sc), vst1 = v_st(32 + sr, sc);
    const int krr = tid >> 3, krc = tid & 7;
    const int vb0 = (int)(uintptr_t)V_lds + v_rd_base(lane);
    struct { bf16x8 vs0, vs1, ks0, ks1, kr; } sr_[1];
#define SLOAD(i, k0) do { sr_[i].vs0 = *reinterpret_cast<const bf16x8*>(&Vh[(long)((k0) + sr) * ldk + sc]); sr_[i].vs1 = *reinterpret_cast<const bf16x8*>(&Vh[(long)((k0) + 32 + sr) * ldk + sc]); \
    sr_[i].ks0 = *reinterpret_cast<const bf16x8*>(&Kh[(long)((k0) + sr) * ldk + sc]); sr_[i].ks1 = *reinterpret_cast<const bf16x8*>(&Kh[(long)((k0) + 32 + sr) * ldk + sc]); \
    if (MODE == 0) sr_[i].kr = *reinterpret_cast<const bf16x8*>(&Krh[(long)((k0) + krr) * 64 + krc * 8]); } while (0)
#define SWRITE(b, i) do { *(bf16x8*)(V_lds + (b) * SHM_V + vst0) = sr_[i].vs0; *(bf16x8*)(V_lds + (b) * SHM_V + vst1) = sr_[i].vs1; const int kc = sc * 2; \
    *(bf16x8*)(K_lds + (b) * SHM_K + KSWZ(sr, kc)) = sr_[i].ks0; *(bf16x8*)(K_lds + (b) * SHM_K + KSWZ(32 + sr, kc)) = sr_[i].ks1; \
    if (MODE == 0) *(bf16x8*)(KR_lds + (b) * SHM_KR + krr * 144 + krc * 16) = sr_[i].kr; } while (0)
#define RESC(a) do { if (__any((a) < 1.f)) { if (hi == 0) al_l[r32] = (a); asm volatile("s_waitcnt lgkmcnt(0)" ::: "memory"); \
    _Pragma("unroll") for (int d = 0; d < 4; ++d) _Pragma("unroll") for (int r = 0; r < 16; ++r) o[d][r] *= al_l[crow(r, hi)]; } } while (0)
#define LOADM(WL, WH, j) do { if (MODE == 1) { const u64 mw_ = Mrow[j]; WL = (unsigned)mw_ >> (4 * hi); WH = (unsigned)(mw_ >> 32) >> (4 * hi); } } while (0)
#define FIXT(P0, P1, j) do { if ((MODE != 2) && (j) >= wnt) { _Pragma("unroll") for (int r = 0; r < 16; ++r) { P0[r] = -1e30f; P1[r] = -1e30f; } } } while (0)
    f32x16 pA0, pA1; float mnA, alA; bf16x8 pa0, pa1, pa2, pa3; unsigned wlA = 0, whA = 0;
    (void)mnA;
    SLOAD(0, 0); asm volatile("s_waitcnt vmcnt(0)" ::: "memory"); SWRITE(0, 0); __syncthreads();
    for (int j = 0; j < NT; ++j) {
        const int bsel = j & 1;
        if (j + 1 < NT) SLOAD(0, (j + 1) * 64);
        SBAR(); LOADM(wlA, whA, j);
        qkt<MODE>(pA0, pA1, K_lds + bsel * SHM_K, KR_lds + bsel * SHM_KR, QR_lds, qr, r32, hi); FIXT(pA0, pA1, j);
        partialSM<MODE>(pA0, pA1, m_reg, mnA, alA, wlA);
        finishSM<MODE>(pA0, pA1, alA, l_reg, pa0, pa1, pa2, pa3, whA);
        RESC(alA); SBAR();
        pv_d0(o, vb0 + bsel * SHM_V, pa0, pa1, pa2, pa3);
        if (j + 1 < NT) { if (bsel) SWRITE(0, 0); else SWRITE(1, 0); }
        __syncthreads();
    }
    if (hi == 0) li_l[r32] = l_reg; asm volatile("s_waitcnt lgkmcnt(0)" ::: "memory");
    float rli[16];
#pragma unroll
    for (int r = 0; r < 16; ++r) rli[r] = __builtin_amdgcn_rcpf(li_l[crow(r, hi)]);
    bf16* Ow = Ob + (long)(wid * 32) * ldo;
#pragma unroll
    for (int r = 0; r < 16; ++r) { const int orow = crow(r, hi);
#pragma unroll
        for (int d0 = 0; d0 < 4; ++d0) Ow[(long)orow * ldo + d0 * 32 + r32] = (bf16)(cvtpk(o[d0][r] * rli[r], 0.f) & 0xffffu); }
#undef SLOAD
#undef SWRITE
#undef RESC
#undef LOADM
#undef FIXT
}
}

__device__ __forceinline__ long sc_rowoff(int t) { const int b = t >> 12, tl = t & 4095, c = tl >> 6; return (long)b * SC_BATCH + 2048L * c * (c + 1) + (long)(tl & 63) * 64 * (c + 1); }
__device__ __forceinline__ void idx_unit(const bf16* __restrict__ QI, const bf16* __restrict__ KI, const float* __restrict__ WI, float* __restrict__ SC, int b, int q32, int half, char* lds, int wave_s) {
    const int lane = lane_id(), wid = wave_s, tid = wid * 64 + lane, r32 = lane & 31, hi = lane >> 5;
    const int t0 = b * SEQ + q32 * 32, ntile = (q32 >> 1) + 1;
    __syncthreads();
#pragma unroll
    for (int i = 0; i < 8; ++i) { const int id = tid + 512 * i, n = id & 31, cc = id >> 5, h = cc >> 3, ks = (cc & 7) >> 1, g = cc & 1;
        *reinterpret_cast<bf16x8*>(lds + ((((h * 4 + ks) * 2 + g) * 32 + n) << 4)) = *reinterpret_cast<const bf16x8*>(QI + (size_t)(t0 + n) * 1024 + cc * 8); }
    if (tid < 128) { const int n = tid & 31, h4 = tid >> 5; const f32x4 x = *(const f32x4*)(WI + (size_t)(t0 + n) * 16 + h4 * 4);
        float* wl = (float*)(lds + 65536);
        wl[(h4 * 4 + 0) * 32 + n] = x[0]; wl[(h4 * 4 + 1) * 32 + n] = x[1]; wl[(h4 * 4 + 2) * 32 + n] = x[2]; wl[(h4 * 4 + 3) * 32 + n] = x[3]; }
    __syncthreads();
    const float* wlr = (const float*)(lds + 65536) + r32;
    const char* qbase = lds + ((hi * 32 + r32) << 4);
    float* srow = SC + sc_rowoff(t0 + r32);
    for (int m = wid; half + 2 * m < ntile; m += 8) {
        const int kt = half + 2 * m; const bf16* kp = KI + (size_t)(b * SEQ + kt * 64 + r32) * 64 + hi * 8;
        bf16x8 ka[2][4];
#pragma unroll
        for (int blk = 0; blk < 2; ++blk)
#pragma unroll
            for (int ks = 0; ks < 4; ++ks) ka[blk][ks] = *reinterpret_cast<const bf16x8*>(kp + blk * 32 * 64 + ks * 16);
        f32x16 S0 = {}, S1 = {};
#pragma unroll 2
        for (int h = 0; h < 16; ++h) {
            bf16x8 q[4];
#pragma unroll
            for (int ks = 0; ks < 4; ++ks) q[ks] = *reinterpret_cast<const bf16x8*>(qbase + h * 4096 + ks * 1024);
            f32x16 c0 = {}, c1 = {};
#pragma unroll
            for (int ks = 0; ks < 4; ++ks) { c0 = __builtin_amdgcn_mfma_f32_32x32x16_bf16(ka[0][ks], q[ks], c0, 0, 0, 0); c1 = __builtin_amdgcn_mfma_f32_32x32x16_bf16(ka[1][ks], q[ks], c1, 0, 0, 0); }
            const float w = wlr[h * 32];
#pragma unroll
            for (int r = 0; r < 16; ++r) { S0[r] = fmaf(fmaxf(c0[r], 0.f), w, S0[r]); S1[r] = fmaf(fmaxf(c1[r], 0.f), w, S1[r]); }
            __builtin_amdgcn_sched_barrier(0);
        }
        float* d = srow + kt * 64 + 4 * hi;
#pragma unroll
        for (int g4 = 0; g4 < 4; ++g4) { *(f32x4*)(d + 8 * g4) = (f32x4){S0[4 * g4], S0[4 * g4 + 1], S0[4 * g4 + 2], S0[4 * g4 + 3]};
                                         *(f32x4*)(d + 32 + 8 * g4) = (f32x4){S1[4 * g4], S1[4 * g4 + 1], S1[4 * g4 + 2], S1[4 * g4 + 3]}; }
    }
}

__device__ __forceinline__ unsigned fkey(float f) { const unsigned u = __float_as_uint(f); return (u & 0x80000000u) ? ~u : (u | 0x80000000u); }
__device__ __forceinline__ void select_query(const float* __restrict__ SC, u64* __restrict__ MASK, int t, int lane) {
    const int tl = t & 4095, cnt = (tl >> 6) + 1;
    const float* row = SC + sc_rowoff(t);
    unsigned key[64];
#pragma unroll
    for (int i = 0; i < 64; ++i) { key[i] = 0u; if (i < cnt) key[i] = fkey(row[i * 64 + lane]); }
    unsigned thr = 0u; int excess = 0;
    if (cnt > 4) {
        unsigned prefix = 0u; int cge = 0;
        for (int bit = 31; bit >= 0; --bit) {
            const unsigned cand = prefix | (1u << bit); int c = 0;
#pragma unroll
            for (int i = 0; i < 64; ++i) if (i < cnt) c += __builtin_popcountll(__ballot(key[i] >= cand));
            if (c >= 256) { prefix = cand; cge = c; if (c == 256) break; }
        }
        thr = prefix; excess = cge - 256;
    }
    u64 mine = 0ull;
#pragma unroll
    for (int i = 0; i < 64; ++i) { u64 w = 0ull; if (i < cnt) w = __ballot(key[i] >= thr); if (lane == i) mine = w; }
    if (excess > 0) {
        for (int i = 63; i >= 0 && excess > 0; --i) {
            u64 tb = 0ull;
#pragma unroll
            for (int k = 0; k < 64; ++k) if (k == i && k < cnt) tb = __ballot(key[k] == thr);
            while (tb != 0ull && excess > 0) { const int hb = 63 - __builtin_clzll(tb); tb &= ~(1ull << hb); if (lane == i) mine &= ~(1ull << hb); --excess; }
        }
    }
    MASK[(size_t)t * 64 + lane] = mine;
}

#define TJOB(W_, K_, NS_, WT_, ND_, RO_, MAP_, GAIN_) do { const int ni_ = ((K_) / 64) * ((ND_) / 32); int first_ = gw - (base % NGW); if (first_ < 0) first_ += NGW; \
            for (int it = first_; it < ni_; it += NGW) transpose_item(W_, K_, NS_, WT_, ND_, RO_, MAP_, GAIN_, scr, it, lane); base += ni_; } while (0)

struct Args { const void* in[20]; float* out; unsigned char* ws; };
typedef const __attribute__((address_space(4))) struct Args CArgs;
#define PHASE_BEGIN CArgs* ka_ = (CArgs*)__builtin_amdgcn_kernarg_segment_ptr(); asm volatile("" : "+s"(ka_)); unsigned char* const ws = ka_->ws; (void)ws;
#define IN_F(k) ((const float*)ka_->in[k])
#define x_in (IN_F(0))
#define mem (IN_F(1))
#define pos ((const int*)ka_->in[2])
#define g_mix (IN_F(3))
#define w_in (IN_F(4))
#define g_cq (IN_F(5))
#define g_ckv (IN_F(6))
#define w_qb (IN_F(7))
#define w_kvb (IN_F(8))
#define w_out (IN_F(9))
#define g_cross (IN_F(10))
#define g_mem (IN_F(11))
#define wq (IN_F(12))
#define wk (IN_F(13))
#define wv (IN_F(14))
#define wo (IN_F(15))
#define g_mlp (IN_F(16))
#define w_up (IN_F(17))
#define w_down (IN_F(18))
#define g_final (IN_F(19))
#define out (ka_->out)
#define WIN ((bf16*)(ws + WS_WIN))
#define WQB ((bf16*)(ws + WS_WQB))
#define WKVB ((bf16*)(ws + WS_WKVB))
#define WOUT ((bf16*)(ws + WS_WOUT))
#define WQC ((bf16*)(ws + WS_WQC))
#define WKVC ((bf16*)(ws + WS_WKVC))
#define WOC ((bf16*)(ws + WS_WOC))
#define WUP ((bf16*)(ws + WS_WUP))
#define WDN ((bf16*)(ws + WS_WDN))
#define H ((bf16*)(ws + WS_H))
#define MEMN ((bf16*)(ws + WS_MEMN))
#define KVC ((bf16*)(ws + WS_KVC))
#define CQ ((bf16*)(ws + WS_CQ))
#define CKV ((bf16*)(ws + WS_CKV))
#define QD ((bf16*)(ws + WS_QD))
#define KD ((bf16*)(ws + WS_KD))
#define VD ((bf16*)(ws + WS_VD))
#define QI ((bf16*)(ws + WS_QI))
#define KI ((bf16*)(ws + WS_KI))
#define WI ((float*)(ws + WS_WI))
#define KR ((bf16*)(ws + WS_KR))
#define QN ((bf16*)(ws + WS_QN))
#define QR ((bf16*)(ws + WS_QR))
#define KN ((bf16*)(ws + WS_KN))
#define VV ((bf16*)(ws + WS_V))
#define SC ((float*)(ws + WS_SC))
#define MASK ((u64*)(ws + WS_MASK))
#define MIX ((bf16*)(ws + WS_MIX))
#define X1B ((bf16*)(ws + WS_X1B))
#define QC ((bf16*)(ws + WS_QC))
#define OC ((bf16*)(ws + WS_OC))
#define X2B ((bf16*)(ws + WS_X2B))
#define U ((bf16*)(ws + WS_U))
#define tabM ((float*)(ws + WS_TABM))
#define tabD ((float*)(ws + WS_TABD))
#define tabI ((float*)(ws + WS_TABI))
#define sscq ((float*)(ws + CTL_SSCQ))
#define ssckv ((float*)(ws + CTL_SSCKV))
#define ss1 ((float*)(ws + CTL_SS1))
#define ss2 ((float*)(ws + CTL_SS2))
#define ss3 ((float*)(ws + CTL_SS3))
#ifndef PHASES
#define PHASES 0xFFF
#endif
__global__ void __launch_bounds__(NWAVES * 64, 2) hymba_fwd(Args args) {
    extern __shared__ __attribute__((aligned(16))) unsigned char lds_raw[];
    LAS unsigned char* lds = (LAS unsigned char*)lds_raw;
    const int wave = __builtin_amdgcn_readfirstlane((int)threadIdx.x >> 6);
    {   const int tid0 = wave * 64 + lane_id();
        for (int u = tid0; u < (LDS_BYTES - MISC_OFF) / 4; u += NWAVES * 64) ((LAS unsigned*)(lds + MISC_OFF))[u] = 0u;
        __syncthreads();
        (void)xcd_barrier_post((unsigned*)(args.ws + WS_CTL) + CW_BAR, (volatile LAS unsigned*)(lds + MISC_OFF + 32)); }
#define G ((int)gridDim.x)
#define bx ((int)blockIdx.x)
#define GRID_BAR() do { CArgs* kb_ = (CArgs*)__builtin_amdgcn_kernarg_segment_ptr(); asm volatile("" : "+s"(kb_)); XcdBarrier bar_; bar_.bar = (unsigned*)(kb_->ws + WS_CTL) + CW_BAR; bar_.x = xb_xcc_id(); \
        bar_.st = (volatile LAS unsigned*)(lds + MISC_OFF + 32); xcd_barrier(bar_); } while (0)
#define PHASE_IDS const int lane = lane_id(), tid = wave * 64 + lane, vcu = (G % 8 == 0) ? (bx % 8) * (G / 8) + bx / 8 : bx, gw = vcu * NWAVES + wave, NGW = G * NWAVES; (void)tid; (void)gw; (void)NGW;

#if (PHASES >> 0) & 1
    { PHASE_BEGIN PHASE_IDS
    {
        LAS float* scr = (LAS float*)(lds + wave * 16384);
        int base = 0;
        TJOB(w_in, 2048, 5008, WIN, 5120, 0, 1, nullptr); TJOB(w_qb, 512, 1536, WQB, 1536, 0, 2, g_cq); TJOB(w_kvb, 256, 2048, WKVB, 2048, 0, 3, g_ckv); TJOB(w_out, 2048, 2048, WOUT, 2048, 0, 0, nullptr);
        TJOB(wq, 2048, 512, WQC, 512, 0, 0, g_cross); TJOB(wk, 2048, 512, WKVC, 512, 0, 0, nullptr); TJOB(wv, 2048, 512, WKVC, 512, 512, 0, nullptr); TJOB(wo, 512, 2048, WOC, 2048, 0, 0, nullptr);
        for (long idx = (long)bx * 512 + tid; idx < (long)T * 56; idx += (long)G * 512) {
            const int t = (int)(idx / 56), f = (int)(idx % 56); const int i = f < 32 ? f : (f < 48 ? f - 32 : f - 48); const double rb = f < 32 ? R32 : (f < 48 ? R16 : R8);
            double fr = 1.0; for (int k = 0; k < i; ++k) fr *= rb;
            double s, c; sincos_d((double)pos[t] * fr, s, c);
            float* tb = f < 32 ? tabM + ((size_t)t * 32 + i) * 2 : (f < 48 ? tabD + ((size_t)t * 16 + i) * 2 : tabI + ((size_t)t * 8 + i) * 2);
            tb[0] = (float)c; tb[1] = (float)s;
        }
        for (int m = gw; m < T; m += NGW) rms_row_to_bf16(x_in + (size_t)m * 2048, g_mix, H + (size_t)m * 2048, lane);
        for (int m = gw; m < NB * NMEM; m += NGW) rms_row_to_bf16(mem + (size_t)m * 2048, g_mem, MEMN + (size_t)m * 2048, lane);
    }
    }
    GRID_BAR();

#endif
#if (PHASES >> 1) & 1
    { PHASE_BEGIN PHASE_IDS
    {
        pg8::Gemm g{H, WIN, T, 5120, 2048}; pg8::StaticOrder S; S.init(T, 5120, G, bx);
        EpiIn E{CQ, CKV, QD, KD, VD, QI, KI, KR, WI, sscq, ssckv, tabM, tabD, tabI};
        pg8::gemm_phase<EpiIn, pg8::StaticOrder, true, true>(lds, g, S, E, wave);
        pg8::Gemm g2{MEMN, WKVC, NB * NMEM, 1024, 2048}; pg8::StaticOrder S2; S2.init(NB * NMEM, 1024, G, (bx + G - (640 % G)) % G);
        EpiPlain E2{KVC, 1024};
        pg8::gemm_phase<EpiPlain, pg8::StaticOrder, true, true>(lds, g2, S2, E2, wave);
    }
    }
    GRID_BAR();

#endif
#if (PHASES >> 2) & 1
    { PHASE_BEGIN PHASE_IDS
    {
#ifndef NO_G2
        pg8::Gemm g{CQ, WQB, T, 1536, 512}; pg8::StaticOrder S; S.init(T, 1536, G, bx);
        EpiQ E{QN, QR, sscq, tabM};
        pg8::gemm_phase<EpiQ, pg8::StaticOrder, true, true>(lds, g, S, E, wave);
        pg8::Gemm g2{CKV, WKVB, T, 2048, 256}; pg8::StaticOrder S2; S2.init(T, 2048, G, (bx + G - (192 % G)) % G);
        EpiKV E2{KN, VV, ssckv};
        pg8::gemm_phase<EpiKV, pg8::StaticOrder, true, true>(lds, g2, S2, E2, wave);
#endif
#ifndef NO_IDX
        for (int w = bx; w < 256; w += G) {
            const int b = w >> 7, j = w & 127, p = j >> 1, half = j & 1;
            idx_unit(QI, KI, WI, SC, b, p, half, (char*)lds_raw, wave);
            idx_unit(QI, KI, WI, SC, b, 127 - p, half, (char*)lds_raw, wave);
        }
#endif
    }
    }
    GRID_BAR();

#endif
#if (PHASES >> 3) & 1
    { PHASE_BEGIN PHASE_IDS
    for (int i = gw; i < 2048; i += NGW) {
        select_query(SC, MASK, i, lane); select_query(SC, MASK, 4095 - i, lane);
        select_query(SC, MASK, SEQ + i, lane); select_query(SC, MASK, SEQ + 4095 - i, lane);
    }
    }
    GRID_BAR();

#endif
#if (PHASES >> 4) & 1
    { PHASE_BEGIN PHASE_IDS
    for (int w = bx; w < 256; w += G) {
        const int qb = w & 15, h = (w >> 4) & 7, b = w >> 7;
#ifndef NO_MLA
        { const int t0 = b * SEQ + qb * 256;
          att::attn_unit<0>(QN + (size_t)t0 * 1024 + h * 128, 1024, QR + (size_t)t0 * 512 + h * 64, 512, KN + (size_t)b * SEQ * 1024 + h * 128, KR + (size_t)b * SEQ * 64,
                            VV + (size_t)b * SEQ * 1024 + h * 128, 1024, MIX + (size_t)t0 * 2048 + h * 128, 2048, nullptr, 4 * (qb + 1), 4 * qb + (wave >> 1) + 1, (char*)lds_raw, wave); }
#endif
    }
    for (int w = bx; w < 256; w += G) {
        const int qb = w & 15, h = (w >> 4) & 7, b = w >> 7;
#ifndef NO_DSA
        { const int qb2 = 15 - qb, t0 = b * SEQ + qb2 * 256;
          att::attn_unit<1>(QD + (size_t)t0 * 1024 + h * 128, 1024, nullptr, 0, KD + (size_t)b * SEQ * 1024 + h * 128, nullptr,
                            VD + (size_t)b * SEQ * 1024 + h * 128, 1024, MIX + (size_t)t0 * 2048 + 1024 + h * 128, 2048, MASK + (size_t)t0 * 64, 4 * (qb2 + 1), 4 * qb2 + (wave >> 1) + 1, (char*)lds_raw, wave); }
#endif
    }
    }
    GRID_BAR();

#endif
#if (PHASES >> 5) & 1
    { PHASE_BEGIN PHASE_IDS
    {
        pg8::Gemm g{MIX, WOUT, T, 2048, 2048}; pg8::StaticOrder S; S.init(T, 2048, G, bx);
        EpiRes<true> E{x_in, out, X1B, ss1};
        pg8::gemm_phase<EpiRes<true>, pg8::StaticOrder, true, true>(lds, g, S, E, wave);
    }
    }
    GRID_BAR();

#endif
#if (PHASES >> 6) & 1
    { PHASE_BEGIN PHASE_IDS
    {
        pg8::Gemm g{X1B, WQC, T, 512, 2048}; pg8::StaticOrder S; S.init(T, 512, G, bx);
        EpiScale<0> E{QC, 512, ss1};
        pg8::gemm_phase<EpiScale<0>, pg8::StaticOrder, true, true>(lds, g, S, E, wave);
        __syncthreads();
        LAS float* scr = (LAS float*)(lds + wave * 16384);
        const int nconv = G > 64 ? G - 64 : G, cid = G > 64 ? bx - 64 : bx;
        if (cid >= 0) {
            const int gw = cid * NWAVES + wave, NGW = nconv * NWAVES; int base = 0;
            TJOB(w_up, 2048, 8192, WUP, 8192, 0, 0, g_mlp); TJOB(w_down, 8192, 2048, WDN, 2048, 0, 0, nullptr);
        }
    }
    }
    GRID_BAR();

#endif
#if (PHASES >> 7) & 1
    { PHASE_BEGIN PHASE_IDS
    for (int w = bx; w < 128; w += G) {
        const int qb = w & 15, h = (w >> 4) & 3, b = w >> 6, t0 = b * SEQ + qb * 256;
        att::attn_unit<2>(QC + (size_t)t0 * 512 + h * 128, 512, nullptr, 0, KVC + (size_t)b * NMEM * 1024 + h * 128, nullptr,
                          KVC + (size_t)b * NMEM * 1024 + 512 + h * 128, 1024, OC + (size_t)t0 * 512 + h * 128, 512, nullptr, 4, 4, (char*)lds_raw, wave);
    }
    }
    GRID_BAR();

#endif
#if (PHASES >> 8) & 1
    { PHASE_BEGIN PHASE_IDS
    {
        pg8::Gemm g{OC, WOC, T, 2048, 512}; pg8::StaticOrder S; S.init(T, 2048, G, bx);
        EpiRes<true> E{out, out, X2B, ss2};
        pg8::gemm_phase<EpiRes<true>, pg8::StaticOrder, true, true>(lds, g, S, E, wave);
    }
    }
    GRID_BAR();

#endif
#if (PHASES >> 9) & 1
    { PHASE_BEGIN PHASE_IDS
    {
        pg8::Gemm g{X2B, WUP, T, 8192, 2048}; pg8::StaticOrder S; S.init(T, 8192, G, bx);
        EpiScale<1> E{U, 8192, ss2};
        pg8::gemm_phase<EpiScale<1>, pg8::StaticOrder, true, true>(lds, g, S, E, wave);
    }
    }
    GRID_BAR();

#endif
#if (PHASES >> 10) & 1
    { PHASE_BEGIN PHASE_IDS
    {
        pg8::Gemm g{U, WDN, T, 2048, 8192}; pg8::StaticOrder S; S.init(T, 2048, G, bx);
        EpiRes<false> E{out, out, nullptr, ss3};
        pg8::gemm_phase<EpiRes<false>, pg8::StaticOrder, true, true>(lds, g, S, E, wave);
    }
    }
    GRID_BAR();

#endif
#if (PHASES >> 11) & 1
    { PHASE_BEGIN PHASE_IDS
    for (int m = gw; m < T; m += NGW) {
        const float rs = 1.0f / sqrtf(ss3[m] * (1.0f / 2048.0f) + EPS);
        f32x4* xr = (f32x4*)(out + (size_t)m * 2048) + lane; const f32x4* gr = (const f32x4*)g_final + lane;
#pragma unroll
        for (int j = 0; j < 8; ++j) xr[64 * j] = xr[64 * j] * rs * gr[64 * j];
    }
    }
#endif
}

#undef G
#undef bx
#undef x_in
#undef mem
#undef pos
#undef g_mix
#undef w_in
#undef g_cq
#undef g_ckv
#undef w_qb
#undef w_kvb
#undef w_out
#undef g_cross
#undef g_mem
#undef wq
#undef wk
#undef wv
#undef wo
#undef g_mlp
#undef w_up
#undef w_down
#undef g_final
#undef out
#undef WIN
#undef WQB
#undef WKVB
#undef WOUT
#undef WQC
#undef WKVC
#undef WOC
#undef WUP
#undef WDN
#undef H
#undef MEMN
#undef KVC
#undef CQ
#undef CKV
#undef QD
#undef KD
#undef VD
#undef QI
#undef KI
#undef WI
#undef KR
#undef QN
#undef QR
#undef KN
#undef VV
#undef SC
#undef MASK
#undef MIX
#undef X1B
#undef QC
#undef OC
#undef X2B
#undef U
#undef tabM
#undef tabD
#undef tabI
#undef sscq
#undef ssckv
#undef ss1
#undef ss2
#undef ss3
extern "C" void kernel_launch(void* const* d_in, const int* in_sizes, int n_in, void* d_out, int out_size, void* d_ws, size_t ws_size, hipStream_t stream) {
    static int grid = 0;
    if (grid == 0) {
        if (n_in != 20 || in_sizes[0] != T * DM || out_size != T * DM || ws_size < WS_END) { fprintf(stderr, "kernel_launch: shape / workspace mismatch (n_in %d, out %d, ws %zu < %zu)\n", n_in, out_size, ws_size, (size_t)WS_END); grid = -1; return; }
        int dev = 0, cus = 0, per_cu = 0;
        if (hipGetDevice(&dev) != hipSuccess || hipDeviceGetAttribute(&cus, hipDeviceAttributeMultiprocessorCount, dev) != hipSuccess) { grid = -1; return; }
        if (hipFuncSetAttribute((const void*)hymba_fwd, hipFuncAttributeMaxDynamicSharedMemorySize, LDS_BYTES) != hipSuccess) { fprintf(stderr, "kernel_launch: hipFuncSetAttribute failed\n"); grid = -1; return; }
        if (hipOccupancyMaxActiveBlocksPerMultiprocessor(&per_cu, (const void*)hymba_fwd, NWAVES * 64, LDS_BYTES) != hipSuccess || per_cu < 1) { fprintf(stderr, "kernel_launch: occupancy query says %d\n", per_cu); (void)hipGetLastError(); grid = -1; return; }
        grid = cus;
    }
    if (grid < 0) return;
    if (hipMemsetAsync((char*)d_ws + WS_CTL, 0, CTL_BYTES, stream) != hipSuccess) return;
    Args a{};
    for (int i = 0; i < 20; ++i) a.in[i] = d_in[i];
    a.out = (float*)d_out; a.ws = (unsigned char*)d_ws;
    hipLaunchKernelGGL(hymba_fwd, dim3(grid), dim3(NWAVES * 64), LDS_BYTES, stream, a);
}
```

```cpp
#include <hip/hip_runtime.h>
#include <cstdio>
#include <cstdint>
#define GAS __attribute__((address_space(1)))
#define LAS __attribute__((address_space(3)))
namespace pg8 {
#define PG8_LAS __attribute__((address_space(3)))
typedef unsigned short bf16_t;
typedef short bf16x8 __attribute__((ext_vector_type(8)));
typedef float f32x4 __attribute__((ext_vector_type(4)));
typedef unsigned u32x4 __attribute__((ext_vector_type(4)));
constexpr int BM = 256, BK = 64, HALF = 128, HTB = HALF * BK * 2  , STAGE_BYTES = 8 * HTB, NXCD = 8, WGM = 8;

__host__ __device__ __forceinline__ int lds_byte(int r, int c) { const int st = (r >> 4) * 2 + (c >> 5), rr = r & 15, cc = c & 31, ob = rr * 64 + cc * 2; return st * 1024 + (ob ^ (((ob >> 9) & 1) << 5)); }
__host__ __device__ __forceinline__ void stage_rc(int b, int& R, int& C) { const int st = b / 1024, sb = b % 1024, swz = sb ^ (((sb >> 9) & 1) << 5); R = (st >> 1) * 16 + swz / 64; C = (st & 1) * 32 + (swz % 64) / 2; }
__host__ __device__ __forceinline__ int perm32(int rho) { const int n = rho >> 4, i = rho & 15; return 8 * (i >> 2) + 4 * n + (i & 3); }

struct Unit { int pm, pn; };
struct Gemm { const bf16_t* A; const bf16_t* Bt; int M, N, K; };

struct StaticOrder {
    int nM, nN, nwg, G, c;
    __host__ __device__ void init(int M, int N, int G_, int c_) { nM = M / BM; nN = N / BM; nwg = nM * nN; G = G_; c = c_; }
    __host__ __device__ bool next(int i, Unit& u) const {
        const long L = (long)i * G + c; if (L >= nwg) return false;
        int wgid = (int)L; { const int q = nwg / NXCD, r = nwg % NXCD, xcd = wgid % NXCD, off = wgid / NXCD; wgid = (xcd < r ? xcd * (q + 1) : r * (q + 1) + (xcd - r) * q) + off; }
        const int nig = WGM * nN, gid = wgid / nig, fm = gid * WGM, gsz = (nM - fm) < WGM ? (nM - fm) : WGM;
        u.pm = fm + ((wgid % nig) % gsz); u.pn = (wgid % nig) / gsz; return true;
    }
    __device__ __forceinline__ void a_ready(const Unit&) const {}
    __device__ __forceinline__ void done(const Unit&) const {}
};
__device__ __forceinline__ unsigned cvt_pk_bf16(float lo, float hi) { unsigned r; asm volatile("v_cvt_pk_bf16_f32 %0, %1, %2" : "=v"(r) : "v"(lo), "v"(hi)); return r; }
template <class Epi, class Sched, bool ALIGN_EPI = false, bool SP2 = false>
__device__ __forceinline__ void gemm_phase(PG8_LAS unsigned char* lds, const Gemm g, const Sched& S, const Epi& E, int wave_s) {
    int lane; asm volatile("v_mbcnt_lo_u32_b32 %0, -1, 0\n\tv_mbcnt_hi_u32_b32 %0, -1, %0" : "=v"(lane));
    const int wid = wave_s, tid = wid * 64 + lane, wr = wid >> 2, wc = wid & 3, fr = lane & 15, fq = lane >> 4;
    const int K = g.K, nt = K / BK;
    unsigned voffA[2], voffB[2];
#pragma unroll
    for (int i = 0; i < 2; ++i) { int R, C; stage_rc(tid * 16 + i * 8192, R, C); const int Rb = Epi::PERM ? ((R & ~31) + perm32(R & 31)) : R;
        voffA[i] = (unsigned)(R * K + C) * 2u; voffB[i] = (unsigned)(Rb * K + C) * 2u; }
    const size_t kstep = (size_t)(BK * 2);
    const size_t hstep = (size_t)HALF * K * 2;
    const size_t tstep = 2 * hstep;
    const unsigned ldsw = (unsigned)wid * 1024u;
    const int aoff = lds_byte(wr * 64 + fr, fq * 8), boff = lds_byte(wc * 32 + fr, fq * 8);
#define PG8_SA(b, h) (((b) * 2 + (h)) * HTB)
#define PG8_SB(b, h) ((4 + (b) * 2 + (h)) * HTB)
#define PG8_STAGE(bufoff, gbase, voff) do { _Pragma("unroll") for (int _i = 0; _i < 2; ++_i) \
        __builtin_amdgcn_global_load_lds((const unsigned*)((const char*)(gbase) + (voff)[_i]), (PG8_LAS unsigned*)(lds + (bufoff) + ldsw + _i * 8192), 16, 0, 0); } while (0)
#define PG8_LDA(dst, b, h) do { _Pragma("unroll") for (int m = 0; m < 4; ++m) _Pragma("unroll") for (int k = 0; k < 2; ++k) dst[m][k] = *(const PG8_LAS bf16x8*)(lds + PG8_SA(b, h) + aoff + m * 2048 + k * 1024); } while (0)
#define PG8_LDB(dst, b, h) do { _Pragma("unroll") for (int n = 0; n < 2; ++n) _Pragma("unroll") for (int k = 0; k < 2; ++k) dst[n][k] = *(const PG8_LAS bf16x8*)(lds + PG8_SB(b, h) + boff + n * 2048 + k * 1024); } while (0)
#define PG8_MMA(ai, bj, At, Bt) do { __builtin_amdgcn_s_setprio(1); _Pragma("unroll") for (int m = 0; m < 4; ++m) _Pragma("unroll") for (int n = 0; n < 2; ++n) _Pragma("unroll") for (int k = 0; k < 2; ++k) \
        acc[ai][bj][m][n] = __builtin_amdgcn_mfma_f32_16x16x32_bf16(Bt[n][k], At[m][k], acc[ai][bj][m][n], 0, 0, 0); __builtin_amdgcn_s_setprio(0); } while (0)
#define PG8_WAIT_V(n) asm volatile("s_waitcnt vmcnt(" #n ")" ::: "memory")
#define PG8_WAIT_L(n) asm volatile("s_waitcnt lgkmcnt(" #n ")" ::: "memory")
#define PG8_BAR __builtin_amdgcn_s_barrier()
#define PG8_SCHED __builtin_amdgcn_sched_barrier(0)
    Unit cur, nxt; int ui = 0;
    if (!S.next(0, cur)) return;
    f32x4 acc[2][2][4][2];
#pragma unroll
    for (int a = 0; a < 2; ++a)
#pragma unroll
        for (int b = 0; b < 2; ++b)
#pragma unroll
            for (int m = 0; m < 4; ++m)
#pragma unroll
                for (int n = 0; n < 2; ++n) acc[a][b][m][n] = (f32x4){0.f, 0.f, 0.f, 0.f};
    bf16x8 At[4][2], B0[2][2], B1[2][2];
    const char* cA = (const char*)g.A + (size_t)cur.pm * tstep; const char* cB = (const char*)g.Bt + (size_t)cur.pn * tstep;
    S.a_ready(cur);
    if constexpr (SP2) {
        PG8_STAGE(PG8_SB(0, 0), cB, voffB); PG8_STAGE(PG8_SB(0, 1), cB + hstep, voffB); PG8_STAGE(PG8_SA(0, 0), cA, voffA); PG8_STAGE(PG8_SA(0, 1), cA + hstep, voffA);
        if (wr == 1) PG8_BAR;
        PG8_WAIT_V(2); PG8_BAR;
        PG8_STAGE(PG8_SB(1, 0), cB + kstep, voffB); PG8_STAGE(PG8_SA(1, 0), cA + kstep, voffA); PG8_STAGE(PG8_SB(1, 1), cB + hstep + kstep, voffB);
        PG8_WAIT_V(6); PG8_BAR;
    } else {
        PG8_STAGE(PG8_SB(0, 0), cB, voffB); PG8_STAGE(PG8_SA(0, 0), cA, voffA); PG8_STAGE(PG8_SB(0, 1), cB + hstep, voffB); PG8_STAGE(PG8_SA(0, 1), cA + hstep, voffA);
        if (wr == 1) PG8_BAR;
        PG8_WAIT_V(4); PG8_BAR;
        PG8_STAGE(PG8_SB(1, 0), cB + kstep, voffB); PG8_STAGE(PG8_SA(1, 0), cA + kstep, voffA); PG8_STAGE(PG8_SB(1, 1), cB + hstep + kstep, voffB);
        PG8_WAIT_V(6); PG8_BAR;
    }
    for (;;) {
        const bool has_next = S.next(ui + 1, nxt);
        const char* nA = has_next ? (const char*)g.A + (size_t)nxt.pm * tstep : cA; const char* nB = has_next ? (const char*)g.Bt + (size_t)nxt.pn * tstep : cB;
        for (int t = 0; t < nt; t += 2) {
            const bool last = (t == nt - 2);
            const char* a1 = cA + (size_t)(t + 1) * kstep;
            const char* a2 = last ? nA : cA + (size_t)(t + 2) * kstep; const char* b2 = last ? nB : cB + (size_t)(t + 2) * kstep;
            const char* a3 = a2 + kstep; const char* b3 = b2 + kstep;
            if (last && has_next) S.a_ready(nxt);
            if constexpr (SP2) {
            PG8_LDB(B0, 0, 0); PG8_LDB(B1, 0, 1); PG8_SCHED; PG8_LDA(At, 0, 0); PG8_STAGE(PG8_SA(1, 1), a1 + hstep, voffA);
            PG8_WAIT_V(8); PG8_WAIT_L(0); PG8_BAR; PG8_MMA(0, 0, At, B0); PG8_MMA(0, 1, At, B1); PG8_BAR; PG8_SCHED;
            PG8_LDA(At, 0, 1); PG8_STAGE(PG8_SB(0, 0), b2, voffB); PG8_STAGE(PG8_SB(0, 1), b2 + hstep, voffB); PG8_STAGE(PG8_SA(0, 0), a2, voffA);
            PG8_WAIT_V(8); PG8_WAIT_L(0); PG8_BAR; PG8_MMA(1, 0, At, B0); PG8_MMA(1, 1, At, B1); PG8_BAR; PG8_SCHED;
            PG8_LDB(B0, 1, 0); PG8_LDB(B1, 1, 1); PG8_SCHED; PG8_LDA(At, 1, 0); PG8_STAGE(PG8_SA(0, 1), a2 + hstep, voffA);
            PG8_WAIT_V(8); PG8_WAIT_L(0); PG8_BAR; PG8_MMA(0, 0, At, B0); PG8_MMA(0, 1, At, B1); PG8_BAR; PG8_SCHED;
            PG8_LDA(At, 1, 1); PG8_STAGE(PG8_SB(1, 0), b3, voffB); PG8_STAGE(PG8_SB(1, 1), b3 + hstep, voffB); PG8_STAGE(PG8_SA(1, 0), a3, voffA);
            PG8_WAIT_V(8); PG8_WAIT_L(0); PG8_BAR; PG8_MMA(1, 0, At, B0); PG8_MMA(1, 1, At, B1); PG8_BAR; PG8_SCHED;
            } else {
            PG8_LDB(B0, 0, 0); PG8_SCHED; PG8_LDA(At, 0, 0); PG8_STAGE(PG8_SA(1, 1), a1 + hstep, voffA);
            PG8_WAIT_L(8); PG8_BAR; PG8_WAIT_L(0); PG8_MMA(0, 0, At, B0); PG8_BAR; PG8_SCHED;
            PG8_LDB(B1, 0, 1); PG8_STAGE(PG8_SB(0, 0), b2, voffB);
            PG8_BAR; PG8_WAIT_L(0); PG8_MMA(0, 1, At, B1); PG8_BAR;
            PG8_LDA(At, 0, 1); PG8_STAGE(PG8_SA(0, 0), a2, voffA);
            PG8_BAR; PG8_WAIT_L(0); PG8_MMA(1, 0, At, B0); PG8_BAR; PG8_SCHED;
            PG8_STAGE(PG8_SB(0, 1), b2 + hstep, voffB);
            PG8_WAIT_V(6); PG8_BAR; PG8_MMA(1, 1, At, B1); PG8_BAR;
            PG8_LDB(B0, 1, 0); PG8_SCHED; PG8_LDA(At, 1, 0); PG8_STAGE(PG8_SA(0, 1), a2 + hstep, voffA);
            PG8_WAIT_L(8); PG8_BAR; PG8_WAIT_L(0); PG8_MMA(0, 0, At, B0); PG8_BAR; PG8_SCHED;
            PG8_LDB(B1, 1, 1); PG8_STAGE(PG8_SB(1, 0), b3, voffB);
            PG8_BAR; PG8_WAIT_L(0); PG8_MMA(0, 1, At, B1); PG8_BAR;
            PG8_LDA(At, 1, 1); PG8_STAGE(PG8_SA(1, 0), a3, voffA);
            PG8_BAR; PG8_WAIT_L(0); PG8_MMA(1, 0, At, B0); PG8_BAR; PG8_SCHED;
            PG8_STAGE(PG8_SB(1, 1), b3 + hstep, voffB);
            PG8_WAIT_V(6); PG8_BAR; PG8_MMA(1, 1, At, B1); PG8_BAR;
            }
        }
        if constexpr (ALIGN_EPI) { if (wr == 0) PG8_BAR; }
        if constexpr (!Epi::AFTER_DRAIN) { E(acc, cur, wr, wc, fr, fq); S.done(cur); }
        if (!has_next) break;
#pragma unroll
        for (int a = 0; a < 2; ++a)
#pragma unroll
            for (int b = 0; b < 2; ++b)
#pragma unroll
                for (int m = 0; m < 4; ++m)
#pragma unroll
                    for (int n = 0; n < 2; ++n) acc[a][b][m][n] = (f32x4){0.f, 0.f, 0.f, 0.f};
        cur = nxt; cA = nA; cB = nB; ++ui;
        if constexpr (ALIGN_EPI) { if (wr == 1) PG8_BAR; }
    }
    PG8_WAIT_V(0);
    if constexpr (!ALIGN_EPI) { if (wr == 0) PG8_BAR; }
    PG8_BAR;
    if constexpr (Epi::AFTER_DRAIN) { E.fused(acc, cur, wr, wc, fr, fq, lds, wid, lane); S.done(cur); }
#undef PG8_SA
#undef PG8_SB
#undef PG8_STAGE
#undef PG8_LDA
#undef PG8_LDB
#undef PG8_MMA
#undef PG8_WAIT_V
#undef PG8_WAIT_L
#undef PG8_BAR
#undef PG8_SCHED
}
}
#define XB_TMO      128
#define XB_XCNT(j)  (256  + 64 * (j))
#define XB_XSUB(j)  (1280 + 64 * (j))
#define XB_XGEN(j)  (2304 + 64 * (j))
#define XB_TOP      3328
#define XB_TOPGEN   3392
#define XCD_BAR_WORDS 3456
#define XB_SPIN_CAP (1u << 18)

__device__ __forceinline__ unsigned xb_ld(unsigned* p)              { return __hip_atomic_load(p, __ATOMIC_RELAXED, __HIP_MEMORY_SCOPE_AGENT); }
__device__ __forceinline__ unsigned xb_add(unsigned* p, unsigned v) { return __hip_atomic_fetch_add(p, v, __ATOMIC_RELAXED, __HIP_MEMORY_SCOPE_AGENT); }
__device__ __forceinline__ unsigned xb_xcc_id() { return (unsigned)__builtin_amdgcn_s_getreg((3 << 11) | 20) & 0xFu; }
#define XB_SPIN(cond, bar) do { unsigned _sp = 0; while (cond) { __builtin_amdgcn_s_sleep(1); \
    if ((++_sp & 255u) == 0u) { if (xb_ld(&(bar)[XB_TMO])) break; if (_sp > XB_SPIN_CAP) { atomicAdd(&(bar)[XB_TMO], 1u); break; } } } } while (0)

struct XcdBarrier {
    unsigned* bar; unsigned x;
    volatile LAS unsigned* st;
};

__device__ __forceinline__ XcdBarrier xcd_barrier_post(unsigned* bar, volatile LAS unsigned* st) {
    XcdBarrier b; b.bar = bar; b.x = xb_xcc_id(); b.st = st;
    if (threadIdx.x == 0) (void)xb_add(&bar[XB_XCNT(b.x)], 1u);
    return b;
}
__device__ __forceinline__ void xcd_barrier_complete(unsigned* bar, unsigned x, unsigned& nloc, unsigned& nx) {
    const unsigned G = gridDim.x * gridDim.y * gridDim.z;
    unsigned sum, cnt, mine, sp = 0u;
    for (;;) {
        sum = 0u; cnt = 0u; mine = 0u;
#pragma unroll
        for (unsigned j = 0; j < 16; ++j) { const unsigned c = xb_ld(&bar[XB_XCNT(j)]); sum += c; cnt += (c > 0u) ? 1u : 0u; mine = (j == x) ? c : mine; }
        if (sum == G) break;
        __builtin_amdgcn_s_sleep(1);
        if ((++sp & 255u) == 0u) { if (xb_ld(&bar[XB_TMO])) break; if (sp > XB_SPIN_CAP) { atomicAdd(&bar[XB_TMO], 1u); break; } }
    }
    nloc = mine > 0u ? mine : 1u; nx = cnt > 0u ? cnt : 1u;
}

__device__ __forceinline__ void xcd_barrier(const XcdBarrier& b) {
    asm volatile("s_waitcnt vmcnt(0)" ::: "memory");
    __syncthreads();
    if (threadIdx.x == 0) {
        unsigned* bar = b.bar;
        __builtin_amdgcn_s_waitcnt(0);
        unsigned nloc = b.st[0], nx = b.st[1];
        if (nloc == 0u) { xcd_barrier_complete(bar, b.x, nloc, nx); b.st[0] = nloc; b.st[1] = nx; }
        const unsigned old = xb_add(&bar[XB_XSUB(b.x)], 1u);
        const unsigned gen = old / nloc;
        if (old + 1u == (gen + 1u) * nloc) {
            __builtin_amdgcn_fence(__ATOMIC_RELEASE, "agent");
            asm volatile("s_waitcnt vmcnt(0)" ::: "memory");
            const unsigned og = xb_add(&bar[XB_TOP], 1u);
            const unsigned tg = og / nx;
            if (og + 1u == (tg + 1u) * nx) xb_add(&bar[XB_TOPGEN], 1u);
            else XB_SPIN(xb_ld(&bar[XB_TOPGEN]) == tg, bar);
            __builtin_amdgcn_fence(__ATOMIC_ACQUIRE, "agent");
            xb_add(&bar[XB_XGEN(b.x)], 1u);
            asm volatile("s_waitcnt vmcnt(0)" ::: "memory");
        } else {
            XB_SPIN(xb_ld(&bar[XB_XGEN(b.x)]) == gen, bar);
            __builtin_amdgcn_fence(__ATOMIC_ACQUIRE, "agent");
            asm volatile("s_waitcnt vmcnt(0)" ::: "memory");
        }
    }
    __syncthreads();
}
typedef unsigned short bf16;
typedef float f32x4 __attribute__((ext_vector_type(4)));
typedef float f32x16 __attribute__((ext_vector_type(16)));
typedef short bf16x8 __attribute__((ext_vector_type(8)));
typedef short s16x4 __attribute__((ext_vector_type(4)));
typedef unsigned u32x4 __attribute__((ext_vector_type(4)));
typedef unsigned long long u64;

constexpr int NB = 2, SEQ = 4096, T = NB * SEQ, DM = 2048, DFF = 8192, NMEM = 256, NWAVES = 8;
constexpr float EPS = 1e-6f;
constexpr size_t MiB = 1u << 20;
constexpr size_t WS_CTL = 0, CTL_BYTES = 1 * MiB;
constexpr size_t WS_TABM = 1 * MiB, WS_TABD = 3 * MiB, WS_TABI = 4 * MiB;
constexpr size_t WS_WUP = 5 * MiB, WS_WDN = 37 * MiB, WS_X2B = 69 * MiB, WS_U = 101 * MiB;
constexpr size_t WS_WQB = 229 * MiB, WS_WKVB = 231 * MiB, WS_WOUT = 232 * MiB, WS_WQC = 240 * MiB, WS_WKVC = 242 * MiB, WS_WOC = 246 * MiB;
constexpr size_t WS_MASK = 248 * MiB, WS_CQ = 252 * MiB, WS_CKV = 260 * MiB, WS_END = 264 * MiB;
constexpr size_t WS_H = 5 * MiB, WS_WIN = 37 * MiB, WS_SC = 5 * MiB, WS_QI = 70 * MiB, WS_KI = 86 * MiB, WS_WI = 87 * MiB, WS_KR = 88 * MiB, WS_MEMN = 89 * MiB, WS_KVC = 91 * MiB;
constexpr size_t WS_QD = 101 * MiB, WS_KD = 117 * MiB, WS_VD = 133 * MiB, WS_QN = 149 * MiB, WS_QR = 165 * MiB, WS_KN = 173 * MiB, WS_V = 189 * MiB;
constexpr size_t WS_MIX = 5 * MiB, WS_X1B = 101 * MiB, WS_QC = 133 * MiB, WS_OC = 141 * MiB;
constexpr int CW_BAR = 4096;
constexpr size_t CTL_SSCQ = 64 * 1024, CTL_SSCKV = 96 * 1024, CTL_SS1 = 128 * 1024, CTL_SS2 = 160 * 1024, CTL_SS3 = 192 * 1024;
constexpr long SC_BATCH = 4096L * 2080L;
constexpr int RING_BYTES = 131072, MISC_OFF = RING_BYTES, LDS_BYTES = 147456;

constexpr double R32 = 0.6636012376960885, R16 = 0.44036660267178046, R8 = 0.19392274474868576;

__device__ __forceinline__ int lane_id() { int l; asm volatile("v_mbcnt_lo_u32_b32 %0, -1, 0\n\tv_mbcnt_hi_u32_b32 %0, -1, %0" : "=v"(l)); return l; }
#define LDS_WAIT() asm volatile("s_waitcnt lgkmcnt(0)" ::: "memory")
#define VM_WAIT() asm volatile("s_waitcnt vmcnt(0)" ::: "memory")
__device__ __forceinline__ unsigned cvtpk(float lo, float hi) { unsigned r; asm volatile("v_cvt_pk_bf16_f32 %0, %1, %2" : "=v"(r) : "v"(lo), "v"(hi)); return r; }
__device__ __forceinline__ void st8(bf16* p, f32x4 a, f32x4 b) { u32x4 w; w.x = cvtpk(a[0], a[1]); w.y = cvtpk(a[2], a[3]); w.z = cvtpk(b[0], b[1]); w.w = cvtpk(b[2], b[3]); *(u32x4*)p = w; }
__device__ __forceinline__ float dot4(f32x4 a) { return (a[0] * a[0] + a[1] * a[1]) + (a[2] * a[2] + a[3] * a[3]); }
__device__ __forceinline__ void fadd_agent(float* p, float v) { (void)__hip_atomic_fetch_add(p, v, __ATOMIC_RELAXED, __HIP_MEMORY_SCOPE_AGENT); }
__device__ __forceinline__ void rope8(f32x4& a, f32x4& b, const float* tb) {
    const f32x4 t0 = *(const f32x4*)tb, t1 = *(const f32x4*)(tb + 4);
    float x1 = a[0], x2 = a[1]; a[0] = x1 * t0[0] - x2 * t0[1]; a[1] = x2 * t0[0] + x1 * t0[1];
    x1 = a[2]; x2 = a[3];       a[2] = x1 * t0[2] - x2 * t0[3]; a[3] = x2 * t0[2] + x1 * t0[3];
    x1 = b[0]; x2 = b[1];       b[0] = x1 * t1[0] - x2 * t1[1]; b[1] = x2 * t1[0] + x1 * t1[1];
    x1 = b[2]; x2 = b[3];       b[2] = x1 * t1[2] - x2 * t1[3]; b[3] = x2 * t1[2] + x1 * t1[3];
}

#define EPI_ROWS_BEGIN \
    const int colt0 = wc * 32 + 8 * fq; \
    _Pragma("unroll") for (int ai = 0; ai < 2; ++ai) _Pragma("unroll") for (int m = 0; m < 4; ++m) { \
        const int row = u.pm * 256 + ai * 128 + wr * 64 + m * 16 + fr; \
        f32x4 a0 = acc[ai][0][m][0], a1 = acc[ai][0][m][1], b0 = acc[ai][1][m][0], b1 = acc[ai][1][m][1];
#define EPI_ROWS_END }

struct EpiIn {
    static constexpr bool PERM = true, AFTER_DRAIN = false;
    bf16 *CQ, *CKV, *QD, *KD, *VD, *QI, *KI, *KR; float* WI; float *sscq, *ssckv; const float *tabM, *tabD, *tabI; bool doss;
    __device__ __forceinline__ void operator()(const f32x4 (&acc)[2][2][4][2], const pg8::Unit& u, int wr, int wc, int fr, int fq) const {
        const int pn = u.pn;
        EPI_ROWS_BEGIN
            if (pn < 3) {
                float s = (dot4(a0) + dot4(a1)) + (dot4(b0) + dot4(b1));
                s += __shfl_xor(s, 16); s += __shfl_xor(s, 32);
                if (pn < 2) { bf16* d = CQ + (size_t)row * 512 + pn * 256 + colt0; st8(d, a0, a1); st8(d + 128, b0, b1); if (fq == 0 && doss) fadd_agent(sscq + row, s); }
                else { bf16* d = CKV + (size_t)row * 256 + colt0; st8(d, a0, a1); st8(d + 128, b0, b1); if (fq == 0 && doss) fadd_agent(ssckv + row, s); }
            } else if (pn < 11) {
                bf16* d = (pn < 7 ? QD : KD) + (size_t)row * 1024 + ((pn - 3) & 3) * 256 + colt0;
                if (wc == 0) { const float* tb = tabD + ((size_t)row * 16 + 4 * fq) * 2; rope8(a0, a1, tb); rope8(b0, b1, tb); }
                st8(d, a0, a1); st8(d + 128, b0, b1);
            } else if (pn < 15) {
                bf16* d = VD + (size_t)row * 1024 + (pn - 11) * 256 + colt0; st8(d, a0, a1); st8(d + 128, b0, b1);
            } else if (pn < 19) {
                bf16* d = QI + (size_t)row * 1024 + (pn - 15) * 256 + colt0;
                if ((wc & 1) == 0 && fq < 2) { const float* tb = tabI + ((size_t)row * 8 + 4 * fq) * 2; rope8(a0, a1, tb); rope8(b0, b1, tb); }
                st8(d, a0, a1); st8(d + 128, b0, b1);
            } else {
                if (wc < 2) { const float* tb = tabM + ((size_t)row * 32 + 16 * wc + 4 * fq) * 2; rope8(a0, a1, tb); st8(KR + (size_t)row * 64 + 32 * wc + 8 * fq, a0, a1); }
                else { if (wc == 2 && fq < 2) { const float* tb = tabI + ((size_t)row * 8 + 4 * fq) * 2; rope8(a0, a1, tb); } st8(KI + (size_t)row * 64 + 32 * (wc - 2) + 8 * fq, a0, a1); }
                if (wc == 0 && fq < 2) { float* d = WI + (size_t)row * 16 + 8 * fq; *(f32x4*)d = b0 * 0.03125f; *(f32x4*)(d + 4) = b1 * 0.03125f; }
            }
        EPI_ROWS_END
    }
};
struct EpiPlain {
    static constexpr bool PERM = true, AFTER_DRAIN = false;
    bf16* O; int ldc;
    __device__ __forceinline__ void operator()(const f32x4 (&acc)[2][2][4][2], const pg8::Unit& u, int wr, int wc, int fr, int fq) const {
        EPI_ROWS_BEGIN
            bf16* d = O + (size_t)row * ldc + u.pn * 256 + colt0; st8(d, a0, a1); st8(d + 128, b0, b1);
        EPI_ROWS_END
    }
};
struct EpiQ {
    static constexpr bool PERM = true, AFTER_DRAIN = false;
    bf16 *QN, *QR; const float* ss; const float* tabM;
    __device__ __forceinline__ void operator()(const f32x4 (&acc)[2][2][4][2], const pg8::Unit& u, int wr, int wc, int fr, int fq) const {
        const int pn = u.pn;
        EPI_ROWS_BEGIN
            const float rs = 1.0f / sqrtf(ss[row] * (1.0f / 512.0f) + EPS);
            a0 = a0 * rs; a1 = a1 * rs; b0 = b0 * rs; b1 = b1 * rs;
            if (pn < 4) { bf16* d = QN + (size_t)row * 1024 + pn * 256 + colt0; st8(d, a0, a1); st8(d + 128, b0, b1); }
            else { const float* tb = tabM + ((size_t)row * 32 + 16 * (wc & 1) + 4 * fq) * 2; rope8(a0, a1, tb); rope8(b0, b1, tb);
                   bf16* d = QR + (size_t)row * 512 + (pn - 4) * 256 + colt0; st8(d, a0, a1); st8(d + 128, b0, b1); }
        EPI_ROWS_END
    }
};
struct EpiKV {
    static constexpr bool PERM = true, AFTER_DRAIN = false;
    bf16 *KN, *V; const float* ss;
    __device__ __forceinline__ void operator()(const f32x4 (&acc)[2][2][4][2], const pg8::Unit& u, int wr, int wc, int fr, int fq) const {
        const int pn = u.pn;
        EPI_ROWS_BEGIN
            const float rs = 1.0f / sqrtf(ss[row] * (1.0f / 256.0f) + EPS);
            bf16* d = (pn < 4 ? KN : V) + (size_t)row * 1024 + (pn & 3) * 256 + colt0; st8(d, a0 * rs, a1 * rs); st8(d + 128, b0 * rs, b1 * rs);
        EPI_ROWS_END
    }
};
template <bool WITH_BF16> struct EpiRes {
    static constexpr bool PERM = true, AFTER_DRAIN = false;
    const float* R; float* X; bf16* Xb; float* ss; float sgn; bool doss;
    __device__ __forceinline__ void operator()(const f32x4 (&acc)[2][2][4][2], const pg8::Unit& u, int wr, int wc, int fr, int fq) const {
        EPI_ROWS_BEGIN
            const size_t off = (size_t)row * 2048 + u.pn * 256 + colt0;
            a0 = a0 * sgn + *(const f32x4*)(R + off); a1 = a1 * sgn + *(const f32x4*)(R + off + 4); b0 = b0 * sgn + *(const f32x4*)(R + off + 128); b1 = b1 * sgn + *(const f32x4*)(R + off + 132);
            *(f32x4*)(X + off) = a0; *(f32x4*)(X + off + 4) = a1; *(f32x4*)(X + off + 128) = b0; *(f32x4*)(X + off + 132) = b1;
            if (WITH_BF16) { st8(Xb + off, a0, a1); st8(Xb + off + 128, b0, b1); }
            float s = (dot4(a0) + dot4(a1)) + (dot4(b0) + dot4(b1));
            s += __shfl_xor(s, 16); s += __shfl_xor(s, 32);
            if (fq == 0 && doss) fadd_agent(ss + row, s);
        EPI_ROWS_END
    }
};
template <int ACT> struct EpiScale {
    static constexpr bool PERM = true, AFTER_DRAIN = false;
    bf16* O; int ldc; const float* ss;
    __device__ __forceinline__ void operator()(const f32x4 (&acc)[2][2][4][2], const pg8::Unit& u, int wr, int wc, int fr, int fq) const {
        EPI_ROWS_BEGIN
            const float rs = 1.0f / sqrtf(ss[row] * (1.0f / 2048.0f) + EPS);
            a0 = a0 * rs; a1 = a1 * rs; b0 = b0 * rs; b1 = b1 * rs;
            if (ACT == 1) {
#pragma unroll
                for (int i = 0; i < 4; ++i) { float v;
                    v = fmaxf(a0[i], 0.f); a0[i] = v * v; v = fmaxf(a1[i], 0.f); a1[i] = v * v; v = fmaxf(b0[i], 0.f); b0[i] = v * v; v = fmaxf(b1[i], 0.f); b1[i] = v * v; }
            }
            bf16* d = O + (size_t)row * ldc + u.pn * 256 + colt0; st8(d, a0, a1); st8(d + 128, b0, b1);
        EPI_ROWS_END
    }
};

struct Frame {
    LAS unsigned char* lds; int tid, lane, wave, vcu, G;
    unsigned char* ws; const void* const* in; float* out;
};
__device__ __forceinline__ float wave_sum(float v) {
#pragma unroll
    for (int o = 1; o < 64; o <<= 1) v += __shfl_xor(v, o);
    return v;
}

__device__ __forceinline__ int ilv(int d, int half) { return (d & 1) ? half + (d >> 1) : (d >> 1); }
__device__ __forceinline__ int srcmap(int id, int n) {
    if (id == 1) {
        if (n < 768) return n;
        if (n < 1792) { const int j = n - 768, h = j >> 7, d = j & 127; return 832 + h * 128 + (d < 32 ? ilv(d, 16) : d); }
        if (n < 2816) { const int j = n - 1792, h = j >> 7, d = j & 127; return 1856 + h * 128 + (d < 32 ? ilv(d, 16) : d); }
        if (n < 3840) return 2880 + (n - 2816);
        if (n < 4864) { const int j = n - 3840, h = j >> 6, d = j & 63; return 3904 + h * 64 + (d < 16 ? ilv(d, 8) : d); }
        const int j = n - 4864;
        if (j < 64) return 768 + ilv(j, 32);
        if (j < 128) { const int d = j - 64; return 4928 + (d < 16 ? ilv(d, 8) : d); }
        if (j < 144) return 4992 + (j - 128);
        return -1;
    }
    if (id == 2) {
        if (n < 1024) { const int h = n >> 7, d = n & 127; return h * 192 + d; }
        const int j = n - 1024, h = j >> 6, d = j & 63; return h * 192 + 128 + ilv(d, 32);
    }
    if (id == 3) {
        if (n < 1024) { const int h = n >> 7, d = n & 127; return h * 256 + d; }
        const int j = n - 1024, h = j >> 7, d = j & 127; return h * 256 + 128 + d;
    }
    return n;
}
__device__ __forceinline__ void transpose_item(const float* W, int K, int Nsrc, bf16* WT, int Ndst, int row_off, int mapid, const float* gain, LAS float* scr, int item, int lane) {
    const int nblk = Ndst / 32, kb = item / nblk, nb = item % nblk, k0 = 64 * kb, n0 = 32 * nb;
    const int nsrc = srcmap(mapid, n0 + (lane & 31));
    float v[32], gg[32];
#pragma unroll
    for (int i = 0; i < 32; ++i) { const int kk = 2 * i + (lane >> 5); v[i] = 0.f; gg[i] = 1.f;
        if (nsrc >= 0) v[i] = W[(size_t)(k0 + kk) * Nsrc + nsrc];
        if (gain) gg[i] = gain[k0 + kk]; }
#pragma unroll
    for (int i = 0; i < 32; ++i) { const int kk = 2 * i + (lane >> 5); scr[kk * 33 + (lane & 31)] = v[i] * gg[i]; }
    LDS_WAIT(); asm volatile("" ::: "memory");
    const int c = lane & 7;
#pragma unroll
    for (int j = 0; j < 4; ++j) { const int n = (lane >> 3) + 8 * j; const LAS float* s = scr + (8 * c) * 33 + n;
        u32x4 o; o.x = cvtpk(s[0 * 33], s[1 * 33]); o.y = cvtpk(s[2 * 33], s[3 * 33]); o.z = cvtpk(s[4 * 33], s[5 * 33]); o.w = cvtpk(s[6 * 33], s[7 * 33]);
        *(u32x4*)(WT + (size_t)(row_off + n0 + n) * K + k0 + 8 * c) = o; }
    LDS_WAIT(); asm volatile("" ::: "memory");
}

__device__ __forceinline__ void rms_row_to_bf16(const float* xrow, const float* g, bf16* orow, int lane) {
    const f32x4* xr = (const f32x4*)xrow + lane; const f32x4* gr = (const f32x4*)g + lane;
    f32x4 v[8]; float s = 0.f;
#pragma unroll
    for (int j = 0; j < 8; ++j) { v[j] = xr[64 * j]; s += dot4(v[j]); }
    const float rs = 1.0f / sqrtf(wave_sum(s) * (1.0f / 2048.0f) + EPS);
    unsigned long long* o8 = (unsigned long long*)orow + lane;
#pragma unroll
    for (int j = 0; j < 8; ++j) { const f32x4 gg = gr[64 * j]; const f32x4 y = v[j] * rs * gg;
        o8[64 * j] = (unsigned long long)cvtpk(y[0], y[1]) | ((unsigned long long)cvtpk(y[2], y[3]) << 32); }
}

__device__ __forceinline__ void sincos_d(double a, double& s, double& c) {
    const double TWO_OVER_PI = 0.63661977236758134308, PIO2_HI = 1.57079632679489655800e+00, PIO2_LO = 6.12323399573676603587e-17;
    const double n = rint(a * TWO_OVER_PI);
    double r = fma(-n, PIO2_HI, a); r = fma(-n, PIO2_LO, r);
    const double r2 = r * r;
    double sp = -1.0 / 1307674368000.0;
    sp = fma(sp, r2, 1.0 / 6227020800.0); sp = fma(sp, r2, -1.0 / 39916800.0); sp = fma(sp, r2, 1.0 / 362880.0);
    sp = fma(sp, r2, -1.0 / 5040.0); sp = fma(sp, r2, 1.0 / 120.0); sp = fma(sp, r2, -1.0 / 6.0); sp = fma(sp * r2, r, r);
    double cp = 1.0 / 20922789888000.0;
    cp = fma(cp, r2, -1.0 / 87178291200.0); cp = fma(cp, r2, 1.0 / 479001600.0); cp = fma(cp, r2, -1.0 / 3628800.0);
    cp = fma(cp, r2, 1.0 / 40320.0); cp = fma(cp, r2, -1.0 / 720.0); cp = fma(cp, r2, 1.0 / 24.0); cp = fma(cp, r2, -0.5); cp = fma(cp, r2, 1.0);
    const int q = ((int)n) & 3;
    s = (q == 0) ? sp : (q == 1) ? cp : (q == 2) ? -sp : -cp;
    c = (q == 0) ? cp : (q == 1) ? -sp : (q == 2) ? -cp : sp;
}

namespace att {
constexpr int SHM_V = 16384, SHM_K = 16384, SHM_KR = 9216, QR_WAVE = 4608;
constexpr int OFF_V = 0, OFF_K = 32768, OFF_KR = 65536, OFF_QR = 83968, OFF_WS = 120832;
#define KSWZ(row, colB) ((row) * 256 + ((colB) ^ (((row) & 7) << 4)))
#define SBAR() __builtin_amdgcn_sched_barrier(0)
__device__ __forceinline__ int crow(int r, int hi) { return (r & 3) + 8 * (r >> 2) + 4 * hi; }
__device__ __forceinline__ float mbit(float p, unsigned w, int pos) { return __uint_as_float(__float_as_uint(p) & (unsigned)(((int)(w << (31 - pos))) >> 31)); }

template <int MODE> __device__ __forceinline__ void partialSM(f32x16& p0, f32x16& p1, float& m_reg, float& mn, float& alpha, unsigned wl) {
    constexpr float SCALE = MODE == 0 ? 0.07216878364870322f : 0.08838834764831845f, C = SCALE * 1.4426950408889634f, THRR = 8.f / SCALE;
    float pmax = p0[0];
#pragma unroll
    for (int r = 1; r < 16; ++r) pmax = fmaxf(pmax, p0[r]);
#pragma unroll
    for (int r = 0; r < 16; ++r) pmax = fmaxf(pmax, p1[r]);
    { auto rr = __builtin_amdgcn_permlane32_swap(__float_as_uint(pmax), __float_as_uint(pmax), false, false);
      pmax = fmaxf(__uint_as_float(rr[0]), __uint_as_float(rr[1])); }
    if (__builtin_expect(__all(pmax - m_reg <= THRR), 1)) { mn = m_reg; alpha = 1.f; }
    else { mn = fmaxf(m_reg, pmax); alpha = __builtin_amdgcn_exp2f((m_reg - mn) * C); m_reg = mn; }
    const float mnC = -mn * C;
#pragma unroll
    for (int r = 0; r < 16; ++r) p0[r] = fmaf(p0[r], C, mnC);
#pragma unroll
    for (int r = 0; r < 16; ++r) p1[r] = fmaf(p1[r], C, mnC);
#pragma unroll
    for (int r = 0; r < 16; ++r) p0[r] = __builtin_amdgcn_exp2f(p0[r]);
    if (MODE == 1) {
#pragma unroll
        for (int r = 0; r < 16; ++r) p0[r] = mbit(p0[r], wl, 8 * (r >> 2) + (r & 3));
    }
}
template <int MODE> __device__ __forceinline__ void finishSM(f32x16& p0, f32x16& p1, float alpha, float& l_reg, bf16x8& pa0, bf16x8& pa1, bf16x8& pa2, bf16x8& pa3, unsigned wh) {
#pragma unroll
    for (int r = 0; r < 16; ++r) p1[r] = __builtin_amdgcn_exp2f(p1[r]);
    if (MODE == 1) {
#pragma unroll
        for (int r = 0; r < 16; ++r) p1[r] = mbit(p1[r], wh, 8 * (r >> 2) + (r & 3));
    }
    float ps = 0;
#pragma unroll
    for (int r = 0; r < 16; ++r) ps += p0[r];
#pragma unroll
    for (int r = 0; r < 16; ++r) ps += p1[r];
    { auto rr = __builtin_amdgcn_permlane32_swap(__float_as_uint(ps), __float_as_uint(ps), false, false);
      ps = __uint_as_float(rr[0]) + __uint_as_float(rr[1]); }
    l_reg = l_reg * alpha + ps;
#define PK4(P, BASE, OUT) do { unsigned a0 = cvtpk(P[BASE + 0], P[BASE + 1]), a1 = cvtpk(P[BASE + 2], P[BASE + 3]);   \
    unsigned b0 = cvtpk(P[BASE + 4], P[BASE + 5]), b1 = cvtpk(P[BASE + 6], P[BASE + 7]);                              \
    auto r0 = __builtin_amdgcn_permlane32_swap(a0, b0, false, false); auto r1 = __builtin_amdgcn_permlane32_swap(a1, b1, false, false); \
    u32x4 w = {r0[0], r1[0], r0[1], r1[1]}; OUT = *reinterpret_cast<bf16x8*>(&w); } while (0)
    PK4(p0, 0, pa0); PK4(p0, 8, pa1); PK4(p1, 0, pa2); PK4(p1, 8, pa3);
#undef PK4
}
template <int MODE> __device__ __forceinline__ void qkt(f32x16& p0, f32x16& p1, const char* Ks, const char* KRs, const char* QRs, const bf16x8* qr, int r32, int hi) {
    p0 = f32x16{}; p1 = f32x16{};
#pragma unroll
    for (int d0 = 0; d0 < 8; ++d0) { const int cb = (d0 * 16 + hi * 8) * 2;
        const bf16x8 b0 = *reinterpret_cast<const bf16x8*>(Ks + KSWZ(r32, cb));
        const bf16x8 b1 = *reinterpret_cast<const bf16x8*>(Ks + KSWZ(32 + r32, cb));
        p0 = __builtin_amdgcn_mfma_f32_32x32x16_bf16(b0, qr[d0], p0, 0, 0, 0);
        p1 = __builtin_amdgcn_mfma_f32_32x32x16_bf16(b1, qr[d0], p1, 0, 0, 0); }
    if (MODE == 0) {
#pragma unroll
        for (int d0 = 0; d0 < 4; ++d0) { const int cb = d0 * 32 + hi * 16;
            const bf16x8 b0 = *reinterpret_cast<const bf16x8*>(KRs + r32 * 144 + cb);
            const bf16x8 b1 = *reinterpret_cast<const bf16x8*>(KRs + (32 + r32) * 144 + cb);
            const bf16x8 qf = *reinterpret_cast<const bf16x8*>(QRs + r32 * 144 + cb);
            p0 = __builtin_amdgcn_mfma_f32_32x32x16_bf16(b0, qf, p0, 0, 0, 0);
            p1 = __builtin_amdgcn_mfma_f32_32x32x16_bf16(b1, qf, p1, 0, 0, 0); }
    }
}
__device__ __forceinline__ int v_st(int k, int c) { const int kk = (k & ~0xC) | ((k & 4) << 1) | ((k & 8) >> 1); return ((kk >> 3) * 4 + (c >> 5)) * 512 + ((kk & 7) * 32 + (c & 31)) * 2; }
__device__ __forceinline__ int v_rd_base(int lane) { return ((lane & 3) << 3) | (((lane >> 2) & 3) << 6) | (((lane >> 4) & 1) << 5) | (((lane >> 5) & 1) << 8); }
constexpr int v_rd_off(int d0, int ks, int half) { return d0 * 512 + ks * 4096 + half * 2048; }
template <int OFF> __device__ __forceinline__ s16x4 tr_read(int vb) {
    s16x4 r; asm volatile("ds_read_b64_tr_b16 %0, %1 offset:%2" : "=&v"(r) : "v"(vb), "i"(OFF) : "memory"); return r;
}
template <int D0> __device__ __forceinline__ void pv_one(f32x16& od, int vb, bf16x8 pa0, bf16x8 pa1, bf16x8 pa2, bf16x8 pa3) {
    const s16x4 l0 = tr_read<v_rd_off(D0, 0, 0)>(vb), h0 = tr_read<v_rd_off(D0, 0, 1)>(vb), l1 = tr_read<v_rd_off(D0, 1, 0)>(vb), h1 = tr_read<v_rd_off(D0, 1, 1)>(vb);
    const s16x4 l2 = tr_read<v_rd_off(D0, 2, 0)>(vb), h2 = tr_read<v_rd_off(D0, 2, 1)>(vb), l3 = tr_read<v_rd_off(D0, 3, 0)>(vb), h3 = tr_read<v_rd_off(D0, 3, 1)>(vb);
    asm volatile("s_waitcnt lgkmcnt(0)" ::: "memory"); SBAR();
#define PK(L, H) (bf16x8){L[0], L[1], L[2], L[3], H[0], H[1], H[2], H[3]}
    od = __builtin_amdgcn_mfma_f32_32x32x16_bf16(pa0, PK(l0, h0), od, 0, 0, 0);
    od = __builtin_amdgcn_mfma_f32_32x32x16_bf16(pa1, PK(l1, h1), od, 0, 0, 0);
    od = __builtin_amdgcn_mfma_f32_32x32x16_bf16(pa2, PK(l2, h2), od, 0, 0, 0);
    od = __builtin_amdgcn_mfma_f32_32x32x16_bf16(pa3, PK(l3, h3), od, 0, 0, 0);
#undef PK
}
__device__ __forceinline__ void pv_d0(f32x16* o, int vb, bf16x8 pa0, bf16x8 pa1, bf16x8 pa2, bf16x8 pa3) {
    pv_one<0>(o[0], vb, pa0, pa1, pa2, pa3); pv_one<1>(o[1], vb, pa0, pa1, pa2, pa3); pv_one<2>(o[2], vb, pa0, pa1, pa2, pa3); pv_one<3>(o[3], vb, pa0, pa1, pa2, pa3);
}

template <int MODE>
__device__ __forceinline__ void attn_unit(const bf16* __restrict__ Qb, int ldq, const bf16* __restrict__ Qrb, int ldqr, const bf16* __restrict__ Kh, const bf16* __restrict__ Krh,
                                          const bf16* __restrict__ Vh, int ldk, bf16* __restrict__ Ob, int ldo, const u64* __restrict__ Mb, int NT, int wnt, char* lds, int wave_s) {
    const int lane = lane_id(), wid = wave_s, tid = wid * 64 + lane, r32 = lane & 31, hi = lane >> 5;
    char* V_lds = lds + OFF_V; char* K_lds = lds + OFF_K; char* KR_lds = lds + OFF_KR; char* QR_lds = lds + OFF_QR + wid * QR_WAVE;
    float* ws = (float*)(lds + OFF_WS) + wid * 64; float* li_l = ws; float* al_l = ws + 32;
    float m_reg = -1e30f, l_reg = 0; f32x16 o[4] = {}; bf16x8 qr[8];
    __syncthreads();
    const bf16* Qw = Qb + (long)(wid * 32 + r32) * ldq + hi * 8;
#pragma unroll
    for (int d0 = 0; d0 < 8; ++d0) qr[d0] = *reinterpret_cast<const bf16x8*>(Qw + d0 * 16);
    if (MODE == 0) {
#pragma unroll
        for (int i = 0; i < 4; ++i) { const int id = lane + 64 * i, row = id >> 3, ch = id & 7;
            *reinterpret_cast<bf16x8*>(QR_lds + row * 144 + ch * 16) = *reinterpret_cast<const bf16x8*>(Qrb + (long)(wid * 32 + row) * ldqr + ch * 8); }
    }
    const u64* Mrow = Mb + (long)(wid * 32 + r32) * 64;
    const int sr = tid >> 4, sc = (tid & 15) * 8, vst0 = v_st(sr, sc), vst1 = v_st(32 + sr, sc);
    const int krr = tid >> 3, krc = tid & 7;
    const int vb0 = (int)(uintptr_t)V_lds + v_rd_base(lane);
    struct { bf16x8 vs0, vs1, ks0, ks1, kr; } sr_[1];
#define SLOAD(i, k0) do { sr_[i].vs0 = *reinterpret_cast<const bf16x8*>(&Vh[(long)((k0) + sr) * ldk + sc]); sr_[i].vs1 = *reinterpret_cast<const bf16x8*>(&Vh[(long)((k0) + 32 + sr) * ldk + sc]); \
    sr_[i].ks0 = *reinterpret_cast<const bf16x8*>(&Kh[(long)((k0) + sr) * ldk + sc]); sr_[i].ks1 = *reinterpret_cast<const bf16x8*>(&Kh[(long)((k0) + 32 + sr) * ldk + sc]); \
    if (MODE == 0) sr_[i].kr = *reinterpret_cast<const bf16x8*>(&Krh[(long)((k0) + krr) * 64 + krc * 8]); } while (0)
#define SWRITE(b, i) do { *(bf16x8*)(V_lds + (b) * SHM_V + vst0) = sr_[i].vs0; *(bf16x8*)(V_lds + (b) * SHM_V + vst1) = sr_[i].vs1; const int kc = sc * 2; \
    *(bf16x8*)(K_lds + (b) * SHM_K + KSWZ(sr, kc)) = sr_[i].ks0; *(bf16x8*)(K_lds + (b) * SHM_K + KSWZ(32 + sr, kc)) = sr_[i].ks1; \
    if (MODE == 0) *(bf16x8*)(KR_lds + (b) * SHM_KR + krr * 144 + krc * 16) = sr_[i].kr; } while (0)
#define RESC(a) do { if (__any((a) < 1.f)) { if (hi == 0) al_l[r32] = (a); asm volatile("s_waitcnt lgkmcnt(0)" ::: "memory"); \
    _Pragma("unroll") for (int d = 0; d < 4; ++d) _Pragma("unroll") for (int r = 0; r < 16; ++r) o[d][r] *= al_l[crow(r, hi)]; } } while (0)
#define LOADM(WL, WH, j) do { if (MODE == 1) { const u64 mw_ = Mrow[j]; WL = (unsigned)mw_ >> (4 * hi); WH = (unsigned)(mw_ >> 32) >> (4 * hi); } } while (0)
#define FIXT(P0, P1, j) do { if ((MODE != 2) && (j) >= wnt) { _Pragma("unroll") for (int r = 0; r < 16; ++r) { P0[r] = -1e30f; P1[r] = -1e30f; } } } while (0)
    f32x16 pA0, pA1; float mnA, alA; bf16x8 pa0, pa1, pa2, pa3; unsigned wlA = 0, whA = 0;
    (void)mnA;
    SLOAD(0, 0); asm volatile("s_waitcnt vmcnt(0)" ::: "memory"); SWRITE(0, 0); __syncthreads();
    for (int j = 0; j < NT; ++j) {
        const int bsel = j & 1;
        if (j + 1 < NT) SLOAD(0, (j + 1) * 64);
        SBAR(); LOADM(wlA, whA, j);
        qkt<MODE>(pA0, pA1, K_lds + bsel * SHM_K, KR_lds + bsel * SHM_KR, QR_lds, qr, r32, hi); FIXT(pA0, pA1, j);
        partialSM<MODE>(pA0, pA1, m_reg, mnA, alA, wlA);
        finishSM<MODE>(pA0, pA1, alA, l_reg, pa0, pa1, pa2, pa3, whA);
        RESC(alA); SBAR();
        pv_d0(o, vb0 + bsel * SHM_V, pa0, pa1, pa2, pa3);
        if (j + 1 < NT) { if (bsel) SWRITE(0, 0); else SWRITE(1, 0); }
        __syncthreads();
    }
    if (hi == 0) li_l[r32] = l_reg; asm volatile("s_waitcnt lgkmcnt(0)" ::: "memory");
    float rli[16];
#pragma unroll
    for (int r = 0; r < 16; ++r) rli[r] = __builtin_amdgcn_rcpf(li_l[crow(r, hi)]);
    bf16* Ow = Ob + (long)(wid * 32) * ldo;
#pragma unroll
    for (int r = 0; r < 16; ++r) { const int orow = crow(r, hi);
#pragma unroll
        for (int d0 = 0; d0 < 4; ++d0) Ow[(long)orow * ldo + d0 * 32 + r32] = (bf16)(cvtpk(o[d0][r] * rli[r], 0.f) & 0xffffu); }
#undef SLOAD
#undef SWRITE
#undef RESC
#undef LOADM
#undef FIXT
}
}

__device__ __forceinline__ long sc_rowoff(int t) { const int b = t >> 12, tl = t & 4095, c = tl >> 6; return (long)b * SC_BATCH + 2048L * c * (c + 1) + (long)(tl & 63) * 64 * (c + 1); }
__device__ __forceinline__ void idx_unit(const bf16* __restrict__ QI, const bf16* __restrict__ KI, const float* __restrict__ WI, float* __restrict__ SC, int b, int q32, int half, char* lds, int wave_s) {
    const int lane = lane_id(), wid = wave_s, tid = wid * 64 + lane, r32 = lane & 31, hi = lane >> 5;
    const int t0 = b * SEQ + q32 * 32, ntile = (q32 >> 1) + 1;
    __syncthreads();
#pragma unroll
    for (int i = 0; i < 8; ++i) { const int id = tid + 512 * i, n = id & 31, cc = id >> 5, h = cc >> 3, ks = (cc & 7) >> 1, g = cc & 1;
        *reinterpret_cast<bf16x8*>(lds + ((((h * 4 + ks) * 2 + g) * 32 + n) << 4)) = *reinterpret_cast<const bf16x8*>(QI + (size_t)(t0 + n) * 1024 + cc * 8); }
    if (tid < 128) { const int n = tid & 31, h4 = tid >> 5; const f32x4 x = *(const f32x4*)(WI + (size_t)(t0 + n) * 16 + h4 * 4);
        float* wl = (float*)(lds + 65536);
        wl[(h4 * 4 + 0) * 32 + n] = x[0]; wl[(h4 * 4 + 1) * 32 + n] = x[1]; wl[(h4 * 4 + 2) * 32 + n] = x[2]; wl[(h4 * 4 + 3) * 32 + n] = x[3]; }
    __syncthreads();
    const float* wlr = (const float*)(lds + 65536) + r32;
    const char* qbase = lds + ((hi * 32 + r32) << 4);
    float* srow = SC + sc_rowoff(t0 + r32);
    for (int m = wid; half + 2 * m < ntile; m += 8) {
        const int kt = half + 2 * m; const bf16* kp = KI + (size_t)(b * SEQ + kt * 64 + r32) * 64 + hi * 8;
        bf16x8 ka[2][4];
#pragma unroll
        for (int blk = 0; blk < 2; ++blk)
#pragma unroll
            for (int ks = 0; ks < 4; ++ks) ka[blk][ks] = *reinterpret_cast<const bf16x8*>(kp + blk * 32 * 64 + ks * 16);
        f32x16 S0 = {}, S1 = {};
#pragma unroll 2
        for (int h = 0; h < 16; ++h) {
            bf16x8 q[4];
#pragma unroll
            for (int ks = 0; ks < 4; ++ks) q[ks] = *reinterpret_cast<const bf16x8*>(qbase + h * 4096 + ks * 1024);
            f32x16 c0 = {}, c1 = {};
#pragma unroll
            for (int ks = 0; ks < 4; ++ks) { c0 = __builtin_amdgcn_mfma_f32_32x32x16_bf16(ka[0][ks], q[ks], c0, 0, 0, 0); c1 = __builtin_amdgcn_mfma_f32_32x32x16_bf16(ka[1][ks], q[ks], c1, 0, 0, 0); }
            const float w = wlr[h * 32];
#pragma unroll
            for (int r = 0; r < 16; ++r) { S0[r] = fmaf(fmaxf(c0[r], 0.f), w, S0[r]); S1[r] = fmaf(fmaxf(c1[r], 0.f), w, S1[r]); }
            __builtin_amdgcn_sched_barrier(0);
        }
        float* d = srow + kt * 64 + 4 * hi;
#pragma unroll
        for (int g4 = 0; g4 < 4; ++g4) { *(f32x4*)(d + 8 * g4) = (f32x4){S0[4 * g4], S0[4 * g4 + 1], S0[4 * g4 + 2], S0[4 * g4 + 3]};
                                         *(f32x4*)(d + 32 + 8 * g4) = (f32x4){S1[4 * g4], S1[4 * g4 + 1], S1[4 * g4 + 2], S1[4 * g4 + 3]}; }
    }
}

__device__ __forceinline__ unsigned fkey(float f) { const unsigned u = __float_as_uint(f); return (u & 0x80000000u) ? ~u : (u | 0x80000000u); }
__device__ __forceinline__ float wave_max(float v) {
#pragma unroll
    for (int o = 1; o < 64; o <<= 1) v = fmaxf(v, __shfl_xor(v, o));
    return v;
}
__device__ __forceinline__ float wave_min(float v) {
#pragma unroll
    for (int o = 1; o < 64; o <<= 1) v = fminf(v, __shfl_xor(v, o));
    return v;
}
__device__ __forceinline__ void select_query(const float* __restrict__ SC, u64* __restrict__ MASK, int t, int lane, LAS float* sl, LAS unsigned* wl) {
    const int tl = t & 4095, cnt = (tl >> 6) + 1;
    u64 mine = 0ull;
    if (cnt <= 4) {
        if (lane < cnt) mine = ~0ull;
        MASK[(size_t)t * 64 + lane] = mine; return;
    }
    const float* row = SC + sc_rowoff(t) + lane;
    LAS float* sp = sl + lane;
    float lo = 3.0e38f, hi = -3.0e38f;
#pragma unroll 8
    for (int i = 0; i < cnt; ++i) { const float v = row[i * 64]; sp[i * 64] = v; lo = fminf(lo, v); hi = fmaxf(hi, v); }
    lo = wave_min(lo); hi = wave_max(hi);
    LDS_WAIT();
    bool done = false;
    if (hi > lo) {
        const float inv = 63.999f / (hi - lo);
        LAS unsigned* h1 = wl; LAS unsigned* h2 = wl + 64; LAS float* cs = (LAS float*)(wl + 128); LAS unsigned* ci = wl + 192;
        h1[lane] = 0u; h2[lane] = 0u;
        LDS_WAIT();
#pragma unroll 4
        for (int i = 0; i < cnt; ++i) { int d1 = (int)((sp[i * 64] - lo) * inv); d1 = d1 > 63 ? 63 : d1; atomicAdd((unsigned*)(h1 + d1), 1u); }
        LDS_WAIT();
        const int hc = (int)h1[lane]; int inc = hc;
#pragma unroll
        for (int o = 1; o < 64; o <<= 1) { const int v = __shfl_down(inc, o); if (lane + o < 64) inc += v; }
        const int ex = inc - hc;
        const u64 bm = __ballot(ex < 256 && inc >= 256);
        const int B1 = (int)__builtin_ctzll(bm | (1ull << 63));
        const int S1 = __builtin_amdgcn_readlane(ex, B1), n1 = __builtin_amdgcn_readlane(hc, B1);
        int B2 = -1, S2 = 0, nc = n1;
        if (n1 > 64) {
#pragma unroll 4
            for (int i = 0; i < cnt; ++i) { const float tt = (sp[i * 64] - lo) * inv; int d1 = (int)tt; d1 = d1 > 63 ? 63 : d1;
                if (d1 == B1) { int d2 = (int)((tt - (float)B1) * 64.f); d2 = d2 > 63 ? 63 : d2; atomicAdd((unsigned*)(h2 + d2), 1u); } }
            LDS_WAIT();
            const int hc2 = (int)h2[lane]; int inc2 = hc2;
#pragma unroll
            for (int o = 1; o < 64; o <<= 1) { const int v = __shfl_down(inc2, o); if (lane + o < 64) inc2 += v; }
            const int ex2 = inc2 - hc2, need1 = 256 - S1;
            const u64 bm2 = __ballot(ex2 < need1 && inc2 >= need1);
            B2 = (int)__builtin_ctzll(bm2 | (1ull << 63));
            S2 = __builtin_amdgcn_readlane(ex2, B2); nc = __builtin_amdgcn_readlane(hc2, B2);
        }
        const int r = 256 - S1 - S2;
        if (nc <= 64 && r >= 1 && r <= nc) {
            int base = 0;
#pragma unroll 4
            for (int i = 0; i < cnt; ++i) { const float sv = sp[i * 64]; const float tt = (sv - lo) * inv; int d1 = (int)tt; d1 = d1 > 63 ? 63 : d1; bool c = (d1 == B1);
                if (B2 >= 0) { int d2 = (int)((tt - (float)B1) * 64.f); d2 = d2 > 63 ? 63 : d2; c = c && (d2 == B2); }
                const u64 m = __ballot(c);
                if (c) { const int p = base + (int)__builtin_amdgcn_mbcnt_hi((unsigned)(m >> 32), __builtin_amdgcn_mbcnt_lo((unsigned)m, 0u)); if (p < 64) { cs[p] = sv; ci[p] = (unsigned)(i * 64 + lane); } }
                base += (int)__builtin_popcountll(m); }
            LDS_WAIT();
            if (base == nc) {
                float sj = 0.f; unsigned ij = 0u; int rank = 0;
                if (lane < nc) { sj = cs[lane]; ij = ci[lane]; }
                for (int m = 0; m < nc; ++m) { const float sm = cs[m]; const unsigned im = ci[m]; rank += (sm > sj || (sm == sj && im < ij)) ? 1 : 0; }
                const u64 tb = __ballot(lane < nc && rank == r - 1);
                if (tb != 0ull) {
                    const int tlane = (int)__builtin_ctzll(tb);
                    const float th = __uint_as_float((unsigned)__builtin_amdgcn_readlane((int)__float_as_uint(sj), tlane)); const unsigned ith = (unsigned)__builtin_amdgcn_readlane((int)ij, tlane);
                    int total = 0;
#pragma unroll 4
                    for (int i = 0; i < cnt; ++i) { const float sv = sp[i * 64]; const u64 w = __ballot(sv > th || (sv == th && (unsigned)(i * 64 + lane) <= ith)); total += (int)__builtin_popcountll(w); mine = (lane == i) ? w : mine; }
                    done = (total == 256);
                }
            }
        }
    }
    if (!done) {
        unsigned prefix = 0u; int cge = 0;
        for (int bit = 31; bit >= 0; --bit) {
            const unsigned cand = prefix | (1u << bit); int c = 0;
            for (int i = 0; i < cnt; ++i) c += __builtin_popcountll(__ballot(fkey(sp[i * 64]) >= cand));
            if (c >= 256) { prefix = cand; cge = c; if (c == 256) break; }
        }
        const unsigned thr = prefix; int excess = cge - 256; mine = 0ull;
        for (int i = 0; i < cnt; ++i) { const u64 w = __ballot(fkey(sp[i * 64]) >= thr); mine = (lane == i) ? w : mine; }
        for (int i = cnt - 1; i >= 0 && excess > 0; --i) {
            u64 tb = __ballot(fkey(sp[i * 64]) == thr);
            while (tb != 0ull && excess > 0) { const int hb = 63 - __builtin_clzll(tb); tb &= ~(1ull << hb); if (lane == i) mine &= ~(1ull << hb); --excess; }
        }
    }
    MASK[(size_t)t * 64 + lane] = mine;
}

#define TJOB(W_, K_, NS_, WT_, ND_, RO_, MAP_, GAIN_) do { const int ni_ = ((K_) / 64) * ((ND_) / 32); int first_ = gw - (base % NGW); if (first_ < 0) first_ += NGW; \
            for (int it = first_; it < ni_; it += NGW) transpose_item(W_, K_, NS_, WT_, ND_, RO_, MAP_, GAIN_, scr, it, lane); base += ni_; } while (0)
struct Args { const void* in[20]; float* out; unsigned char* ws; };
typedef const __attribute__((address_space(4))) struct Args CArgs;
#define PHASE_BEGIN CArgs* ka_ = (CArgs*)__builtin_amdgcn_kernarg_segment_ptr(); asm volatile("" : "+s"(ka_)); unsigned char* const ws = ka_->ws; (void)ws;
#define IN_F(k) ((const float*)ka_->in[k])
#define x_in (IN_F(0))
#define mem (IN_F(1))
#define pos ((const int*)ka_->in[2])
#define g_mix (IN_F(3))
#define w_in (IN_F(4))
#define g_cq (IN_F(5))
#define g_ckv (IN_F(6))
#define w_qb (IN_F(7))
#define w_kvb (IN_F(8))
#define w_out (IN_F(9))
#define g_cross (IN_F(10))
#define g_mem (IN_F(11))
#define wq (IN_F(12))
#define wk (IN_F(13))
#define wv (IN_F(14))
#define wo (IN_F(15))
#define g_mlp (IN_F(16))
#define w_up (IN_F(17))
#define w_down (IN_F(18))
#define g_final (IN_F(19))
#define out (ka_->out)
#define WIN ((bf16*)(ws + WS_WIN))
#define WQB ((bf16*)(ws + WS_WQB))
#define WKVB ((bf16*)(ws + WS_WKVB))
#define WOUT ((bf16*)(ws + WS_WOUT))
#define WQC ((bf16*)(ws + WS_WQC))
#define WKVC ((bf16*)(ws + WS_WKVC))
#define WOC ((bf16*)(ws + WS_WOC))
#define WUP ((bf16*)(ws + WS_WUP))
#define WDN ((bf16*)(ws + WS_WDN))
#define H ((bf16*)(ws + WS_H))
#define MEMN ((bf16*)(ws + WS_MEMN))
#define KVC ((bf16*)(ws + WS_KVC))
#define CQ ((bf16*)(ws + WS_CQ))
#define CKV ((bf16*)(ws + WS_CKV))
#define QD ((bf16*)(ws + WS_QD))
#define KD ((bf16*)(ws + WS_KD))
#define VD ((bf16*)(ws + WS_VD))
#define QI ((bf16*)(ws + WS_QI))
#define KI ((bf16*)(ws + WS_KI))
#define WI ((float*)(ws + WS_WI))
#define KR ((bf16*)(ws + WS_KR))
#define QN ((bf16*)(ws + WS_QN))
#define QR ((bf16*)(ws + WS_QR))
#define KN ((bf16*)(ws + WS_KN))
#define VV ((bf16*)(ws + WS_V))
#define SC ((float*)(ws + WS_SC))
#define MASK ((u64*)(ws + WS_MASK))
#define MIX ((bf16*)(ws + WS_MIX))
#define X1B ((bf16*)(ws + WS_X1B))
#define QC ((bf16*)(ws + WS_QC))
#define OC ((bf16*)(ws + WS_OC))
#define X2B ((bf16*)(ws + WS_X2B))
#define U ((bf16*)(ws + WS_U))
#define tabM ((float*)(ws + WS_TABM))
#define tabD ((float*)(ws + WS_TABD))
#define tabI ((float*)(ws + WS_TABI))
#define sscq ((float*)(ws + CTL_SSCQ))
#define ssckv ((float*)(ws + CTL_SSCKV))
#define ss1 ((float*)(ws + CTL_SS1))
#define ss2 ((float*)(ws + CTL_SS2))
#define ss3 ((float*)(ws + CTL_SS3))
#ifndef DUP
#define DUP -1
#endif
#ifndef DUPN
#define DUPN 2
#endif
#define NREP(k) (((k) == DUP) ? DUPN : 1)
#ifndef PHASES
#define PHASES 0xFFF
#endif
__global__ void __launch_bounds__(NWAVES * 64, 2) hymba_fwd(Args args) {
    extern __shared__ __attribute__((aligned(16))) unsigned char lds_raw[];
    LAS unsigned char* lds = (LAS unsigned char*)lds_raw;
    const int wave = __builtin_amdgcn_readfirstlane((int)threadIdx.x >> 6);
    {   const int tid0 = wave * 64 + lane_id();
        for (int u = tid0; u < (LDS_BYTES - MISC_OFF) / 4; u += NWAVES * 64) ((LAS unsigned*)(lds + MISC_OFF))[u] = 0u;
        __syncthreads();
        (void)xcd_barrier_post((unsigned*)(args.ws + WS_CTL) + CW_BAR, (volatile LAS unsigned*)(lds + MISC_OFF + 32)); }
#define G ((int)gridDim.x)
#define bx ((int)blockIdx.x)
#define GRID_BAR() do { CArgs* kb_ = (CArgs*)__builtin_amdgcn_kernarg_segment_ptr(); asm volatile("" : "+s"(kb_)); XcdBarrier bar_; bar_.bar = (unsigned*)(kb_->ws + WS_CTL) + CW_BAR; bar_.x = xb_xcc_id(); \
        bar_.st = (volatile LAS unsigned*)(lds + MISC_OFF + 32); xcd_barrier(bar_); } while (0)
#define PHASE_IDS const int lane = lane_id(), tid = wave * 64 + lane, vcu = (G % 8 == 0) ? (bx % 8) * (G / 8) + bx / 8 : bx, gw = vcu * NWAVES + wave, NGW = G * NWAVES; (void)tid; (void)gw; (void)NGW;

#if (PHASES >> 0) & 1
    _Pragma("unroll") for (int rep = 0; rep < NREP(0); ++rep) {
    { PHASE_BEGIN PHASE_IDS
    {
        LAS float* scr = (LAS float*)(lds + wave * 16384);
        int base = 0;
        TJOB(w_in, 2048, 5008, WIN, 5120, 0, 1, nullptr); TJOB(w_qb, 512, 1536, WQB, 1536, 0, 2, g_cq); TJOB(w_kvb, 256, 2048, WKVB, 2048, 0, 3, g_ckv); TJOB(w_out, 2048, 2048, WOUT, 2048, 0, 0, nullptr);
        TJOB(wq, 2048, 512, WQC, 512, 0, 0, g_cross); TJOB(wk, 2048, 512, WKVC, 512, 0, 0, nullptr); TJOB(wv, 2048, 512, WKVC, 512, 512, 0, nullptr); TJOB(wo, 512, 2048, WOC, 2048, 0, 0, nullptr);
        for (long idx = (long)bx * 512 + tid; idx < (long)T * 56; idx += (long)G * 512) {
            const int t = (int)(idx / 56), f = (int)(idx % 56); const int i = f < 32 ? f : (f < 48 ? f - 32 : f - 48); const double rb = f < 32 ? R32 : (f < 48 ? R16 : R8);
            double fr = 1.0; for (int k = 0; k < i; ++k) fr *= rb;
            double s, c; sincos_d((double)pos[t] * fr, s, c);
            float* tb = f < 32 ? tabM + ((size_t)t * 32 + i) * 2 : (f < 48 ? tabD + ((size_t)t * 16 + i) * 2 : tabI + ((size_t)t * 8 + i) * 2);
            tb[0] = (float)c; tb[1] = (float)s;
        }
        for (int m = gw; m < T; m += NGW) rms_row_to_bf16(x_in + (size_t)m * 2048, g_mix, H + (size_t)m * 2048, lane);
        for (int m = gw; m < NB * NMEM; m += NGW) rms_row_to_bf16(mem + (size_t)m * 2048, g_mem, MEMN + (size_t)m * 2048, lane);
    }
    }
    GRID_BAR();
    }

#endif
#if (PHASES >> 1) & 1
    _Pragma("unroll") for (int rep = 0; rep < NREP(1); ++rep) {
    { PHASE_BEGIN PHASE_IDS
    {
        pg8::Gemm g{H, WIN, T, 5120, 2048}; pg8::StaticOrder S; S.init(T, 5120, G, bx);
        EpiIn E{CQ, CKV, QD, KD, VD, QI, KI, KR, WI, sscq, ssckv, tabM, tabD, tabI, rep == NREP(1) - 1};
        pg8::gemm_phase<EpiIn, pg8::StaticOrder, true, true>(lds, g, S, E, wave);
        pg8::Gemm g2{MEMN, WKVC, NB * NMEM, 1024, 2048}; pg8::StaticOrder S2; S2.init(NB * NMEM, 1024, G, (bx + G - (640 % G)) % G);
        EpiPlain E2{KVC, 1024};
        pg8::gemm_phase<EpiPlain, pg8::StaticOrder, true, true>(lds, g2, S2, E2, wave);
    }
    }
    GRID_BAR();
    }

#endif
#if (PHASES >> 2) & 1
    _Pragma("unroll") for (int rep = 0; rep < NREP(2); ++rep) {
    { PHASE_BEGIN PHASE_IDS
    {
#ifndef NO_G2
        pg8::Gemm g{CQ, WQB, T, 1536, 512}; pg8::StaticOrder S; S.init(T, 1536, G, bx);
        EpiQ E{QN, QR, sscq, tabM};
        pg8::gemm_phase<EpiQ, pg8::StaticOrder, true, true>(lds, g, S, E, wave);
        pg8::Gemm g2{CKV, WKVB, T, 2048, 256}; pg8::StaticOrder S2; S2.init(T, 2048, G, (bx + G - (192 % G)) % G);
        EpiKV E2{KN, VV, ssckv};
        pg8::gemm_phase<EpiKV, pg8::StaticOrder, true, true>(lds, g2, S2, E2, wave);
#endif
#ifndef NO_IDX
        for (int w = bx; w < 256; w += G) {
            const int b = w >> 7, j = w & 127, p = j >> 1, half = j & 1;
            idx_unit(QI, KI, WI, SC, b, p, half, (char*)lds_raw, wave);
            idx_unit(QI, KI, WI, SC, b, 127 - p, half, (char*)lds_raw, wave);
        }
#endif
    }
    }
    GRID_BAR();
    }

#endif
#if (PHASES >> 3) & 1
    _Pragma("unroll") for (int rep = 0; rep < NREP(3); ++rep) {
    { PHASE_BEGIN PHASE_IDS
    for (int i = gw; i < 2048; i += NGW) {
        LAS float* sl = (LAS float*)(lds + wave * 16384); LAS unsigned* wl = (LAS unsigned*)(lds + MISC_OFF + 1024 + wave * 1024);
        select_query(SC, MASK, i, lane, sl, wl); select_query(SC, MASK, 4095 - i, lane, sl, wl);
        select_query(SC, MASK, SEQ + i, lane, sl, wl); select_query(SC, MASK, SEQ + 4095 - i, lane, sl, wl);
    }
    }
    GRID_BAR();
    }

#endif
#if (PHASES >> 4) & 1
    _Pragma("unroll") for (int rep = 0; rep < NREP(4); ++rep) {
    { PHASE_BEGIN PHASE_IDS
    for (int w = bx; w < 256; w += G) {
        const int qb = w & 15, h = (w >> 4) & 7, b = w >> 7;
#ifndef NO_MLA
        { const int t0 = b * SEQ + qb * 256;
          att::attn_unit<0>(QN + (size_t)t0 * 1024 + h * 128, 1024, QR + (size_t)t0 * 512 + h * 64, 512, KN + (size_t)b * SEQ * 1024 + h * 128, KR + (size_t)b * SEQ * 64,
                            VV + (size_t)b * SEQ * 1024 + h * 128, 1024, MIX + (size_t)t0 * 2048 + h * 128, 2048, nullptr, 4 * (qb + 1), 4 * qb + (wave >> 1) + 1, (char*)lds_raw, wave); }
#endif
    }
    for (int w = bx; w < 256; w += G) {
        const int qb = w & 15, h = (w >> 4) & 7, b = w >> 7;
#ifndef NO_DSA
        { const int qb2 = 15 - qb, t0 = b * SEQ + qb2 * 256;
          att::attn_unit<1>(QD + (size_t)t0 * 1024 + h * 128, 1024, nullptr, 0, KD + (size_t)b * SEQ * 1024 + h * 128, nullptr,
                            VD + (size_t)b * SEQ * 1024 + h * 128, 1024, MIX + (size_t)t0 * 2048 + 1024 + h * 128, 2048, MASK + (size_t)t0 * 64, 4 * (qb2 + 1), 4 * qb2 + (wave >> 1) + 1, (char*)lds_raw, wave); }
#endif
    }
    }
    GRID_BAR();
    }

#endif
#if (PHASES >> 5) & 1
    _Pragma("unroll") for (int rep = 0; rep < NREP(5); ++rep) {
    { PHASE_BEGIN PHASE_IDS
    {
        pg8::Gemm g{MIX, WOUT, T, 2048, 2048}; pg8::StaticOrder S; S.init(T, 2048, G, bx);
        EpiRes<true> E{x_in, out, X1B, ss1, 1.f, rep == NREP(5) - 1};
        pg8::gemm_phase<EpiRes<true>, pg8::StaticOrder, true, true>(lds, g, S, E, wave);
    }
    }
    GRID_BAR();
    }

#endif
#if (PHASES >> 6) & 1
    _Pragma("unroll") for (int rep = 0; rep < NREP(6); ++rep) {
    { PHASE_BEGIN PHASE_IDS
    {
        pg8::Gemm g{X1B, WQC, T, 512, 2048}; pg8::StaticOrder S; S.init(T, 512, G, bx);
        EpiScale<0> E{QC, 512, ss1};
        pg8::gemm_phase<EpiScale<0>, pg8::StaticOrder, true, true>(lds, g, S, E, wave);
        __syncthreads();
        LAS float* scr = (LAS float*)(lds + wave * 16384);
        const int nconv = G > 64 ? G - 64 : G, cid = G > 64 ? bx - 64 : bx;
        if (cid >= 0) {
            const int gw = cid * NWAVES + wave, NGW = nconv * NWAVES; int base = 0;
            TJOB(w_up, 2048, 8192, WUP, 8192, 0, 0, g_mlp); TJOB(w_down, 8192, 2048, WDN, 2048, 0, 0, nullptr);
        }
    }
    }
    GRID_BAR();
    }

#endif
#if (PHASES >> 7) & 1
    _Pragma("unroll") for (int rep = 0; rep < NREP(7); ++rep) {
    { PHASE_BEGIN PHASE_IDS
    for (int w = bx; w < 128; w += G) {
        const int qb = w & 15, h = (w >> 4) & 3, b = w >> 6, t0 = b * SEQ + qb * 256;
        att::attn_unit<2>(QC + (size_t)t0 * 512 + h * 128, 512, nullptr, 0, KVC + (size_t)b * NMEM * 1024 + h * 128, nullptr,
                          KVC + (size_t)b * NMEM * 1024 + 512 + h * 128, 1024, OC + (size_t)t0 * 512 + h * 128, 512, nullptr, 4, 4, (char*)lds_raw, wave);
    }
    }
    GRID_BAR();
    }

#endif
#if (PHASES >> 8) & 1
    _Pragma("unroll") for (int rep = 0; rep < NREP(8); ++rep) {
    { PHASE_BEGIN PHASE_IDS
    {
        pg8::Gemm g{OC, WOC, T, 2048, 512}; pg8::StaticOrder S; S.init(T, 2048, G, bx);
        EpiRes<true> E{out, out, X2B, ss2, (rep & 1) ? -1.f : 1.f, rep == NREP(8) - 1};
        pg8::gemm_phase<EpiRes<true>, pg8::StaticOrder, true, true>(lds, g, S, E, wave);
    }
    }
    GRID_BAR();
    }

#endif
#if (PHASES >> 9) & 1
    _Pragma("unroll") for (int rep = 0; rep < NREP(9); ++rep) {
    { PHASE_BEGIN PHASE_IDS
    {
        pg8::Gemm g{X2B, WUP, T, 8192, 2048}; pg8::StaticOrder S; S.init(T, 8192, G, bx);
        EpiScale<1> E{U, 8192, ss2};
        pg8::gemm_phase<EpiScale<1>, pg8::StaticOrder, true, true>(lds, g, S, E, wave);
    }
    }
    GRID_BAR();
    }

#endif
#if (PHASES >> 10) & 1
    _Pragma("unroll") for (int rep = 0; rep < NREP(10); ++rep) {
    { PHASE_BEGIN PHASE_IDS
    {
        pg8::Gemm g{U, WDN, T, 2048, 8192}; pg8::StaticOrder S; S.init(T, 2048, G, bx);
        EpiRes<false> E{out, out, nullptr, ss3, (rep & 1) ? -1.f : 1.f, rep == NREP(10) - 1};
        pg8::gemm_phase<EpiRes<false>, pg8::StaticOrder, true, true>(lds, g, S, E, wave);
    }
    }
    GRID_BAR();
    }

#endif
#if (PHASES >> 11) & 1
    _Pragma("unroll") for (int rep = 0; rep < NREP(11); ++rep) {
    { PHASE_BEGIN PHASE_IDS
    for (int m = gw; m < T; m += NGW) {
        const float rs = 1.0f / sqrtf(ss3[m] * (1.0f / 2048.0f) + EPS);
        f32x4* xr = (f32x4*)(out + (size_t)m * 2048) + lane; const f32x4* gr = (const f32x4*)g_final + lane;
#pragma unroll
        for (int j = 0; j < 8; ++j) xr[64 * j] = xr[64 * j] * rs * gr[64 * j];
    }
    }
    }
#endif
}

#undef G
#undef bx
#undef x_in
#undef mem
#undef pos
#undef g_mix
#undef w_in
#undef g_cq
#undef g_ckv
#undef w_qb
#undef w_kvb
#undef w_out
#undef g_cross
#undef g_mem
#undef wq
#undef wk
#undef wv
#undef wo
#undef g_mlp
#undef w_up
#undef w_down
#undef g_final
#undef out
#undef WIN
#undef WQB
#undef WKVB
#undef WOUT
#undef WQC
#undef WKVC
#undef WOC
#undef WUP
#undef WDN
#undef H
#undef MEMN
#undef KVC
#undef CQ
#undef CKV
#undef QD
#undef KD
#undef VD
#undef QI
#undef KI
#undef WI
#undef KR
#undef QN
#undef QR
#undef KN
#undef VV
#undef SC
#undef MASK
#undef MIX
#undef X1B
#undef QC
#undef OC
#undef X2B
#undef U
#undef tabM
#undef tabD
#undef tabI
#undef sscq
#undef ssckv
#undef ss1
#undef ss2
#undef ss3
extern "C" void kernel_launch(void* const* d_in, const int* in_sizes, int n_in, void* d_out, int out_size, void* d_ws, size_t ws_size, hipStream_t stream) {
    static int grid = 0;
    if (grid == 0) {
        if (n_in != 20 || in_sizes[0] != T * DM || out_size != T * DM || ws_size < WS_END) { fprintf(stderr, "kernel_launch: shape / workspace mismatch (n_in %d, out %d, ws %zu < %zu)\n", n_in, out_size, ws_size, (size_t)WS_END); grid = -1; return; }
        int dev = 0, cus = 0, per_cu = 0;
        if (hipGetDevice(&dev) != hipSuccess || hipDeviceGetAttribute(&cus, hipDeviceAttributeMultiprocessorCount, dev) != hipSuccess) { grid = -1; return; }
        if (hipFuncSetAttribute((const void*)hymba_fwd, hipFuncAttributeMaxDynamicSharedMemorySize, LDS_BYTES) != hipSuccess) { fprintf(stderr, "kernel_launch: hipFuncSetAttribute failed\n"); grid = -1; return; }
        if (hipOccupancyMaxActiveBlocksPerMultiprocessor(&per_cu, (const void*)hymba_fwd, NWAVES * 64, LDS_BYTES) != hipSuccess || per_cu < 1) { fprintf(stderr, "kernel_launch: occupancy query says %d\n", per_cu); (void)hipGetLastError(); grid = -1; return; }
        grid = cus;
    }
    if (grid < 0) return;
    if (hipMemsetAsync((char*)d_ws + WS_CTL, 0, CTL_BYTES, stream) != hipSuccess) return;
    Args a{};
    for (int i = 0; i < 20; ++i) a.in[i] = d_in[i];
    a.out = (float*)d_out; a.ws = (unsigned char*)d_ws;
    hipLaunchKernelGGL(hymba_fwd, dim3(grid), dim3(NWAVES * 64), LDS_BYTES, stream, a);
}
```
